# Optimizing an MI355X kernel written in HIP

```python
import jax, jax.numpy as jnp
from jax import lax
import numpy as np

D_MODEL = 4096
BATCH = 4
SEQ = 2048
DEPTH = 1
DEC_BATCH = 128
DEC_SEQ = 1
PAST_LEN = 16384
PAGE_SIZE = 128

CHUNK = 128
A_WIDTH = 2048
A_GROUPS = 4
RET_HEADS = 8
RET_HEAD_DIM = 256
RET_WIDTH = RET_HEADS * RET_HEAD_DIM
MEM_LEN = 256
MEM_HEADS = 4
MEM_HEAD_DIM = 256
MEM_WIDTH = MEM_HEADS * MEM_HEAD_DIM
N_BRANCH = 3
ROPE_BASE = 10000.0
EPS = 1e-6
SPLITS = (A_WIDTH, A_WIDTH, A_WIDTH, RET_WIDTH, RET_WIDTH, RET_WIDTH, RET_WIDTH,
          MEM_WIDTH, MEM_WIDTH, N_BRANCH * D_MODEL)
IN_WIDTH = sum(SPLITS)

kernel_name = "gated_gmlp_retention_memory_decoder_step"


def _chunk_len(s):
    return CHUNK if s % CHUNK == 0 else s


def rms_norm(x, g):
    xf = x.astype(jnp.float32)
    y = xf * lax.rsqrt(jnp.mean(xf * xf, axis=-1, keepdims=True) + EPS)
    return (y * g.astype(jnp.float32)).astype(x.dtype)


def layer_norm(x, g):
    xf = x.astype(jnp.float32)
    mu = jnp.mean(xf, axis=-1, keepdims=True)
    var = jnp.mean(jnp.square(xf - mu), axis=-1, keepdims=True)
    return ((xf - mu) * lax.rsqrt(var + EPS) * g.astype(jnp.float32)).astype(x.dtype)


def rotary(x, pos):
    half = x.shape[-1] // 2
    inv = ROPE_BASE ** (-jnp.arange(half, dtype=jnp.float32) / half)
    ang = pos.astype(jnp.float32)[:, None] * inv[None, :]
    cos = jnp.cos(ang)[None, :, None, :]
    sin = jnp.sin(ang)[None, :, None, :]
    xf = x.astype(jnp.float32)
    x1, x2 = xf[..., :half], xf[..., half:]
    return jnp.concatenate([x1 * cos - x2 * sin, x1 * sin + x2 * cos], axis=-1)


def chunk_spatial(v, w_s, b_s):
    B, S, _ = v.shape
    L = _chunk_len(S)
    n = S // L
    mask = jnp.tril(jnp.ones((L, L), dtype=bool))
    w = jnp.where(mask[None], w_s[:, :L, :L], 0.0).astype(v.dtype)
    vg = v.reshape(B, n, L, A_GROUPS, A_WIDTH // A_GROUPS)
    out = jnp.einsum('gij,bnjgc->bnigc', w, vg) + b_s[:, :L].T.astype(v.dtype)[None, None, :, :, None]
    return out.reshape(B, S, A_WIDTH)


def retention(q, k, v, state):
    B, S, H, _ = q.shape
    L = _chunk_len(S)
    n = S // L
    log_gamma = jnp.log1p(-jnp.exp2(-5.0 - jnp.arange(H, dtype=jnp.float32)))
    idx = jnp.arange(L, dtype=jnp.float32)
    diff = idx[:, None] - idx[None, :]
    decay_in = jnp.where(diff[None] >= 0, jnp.exp(log_gamma[:, None, None] * jnp.maximum(diff, 0.0)[None]), 0.0)
    decay_q = jnp.exp(log_gamma[:, None] * (idx[None, :] + 1.0))
    decay_k = jnp.exp(log_gamma[:, None] * (L - 1.0 - idx[None, :]))
    decay_blk = jnp.exp(log_gamma * L)

    def to_blocks(t):
        return t.astype(jnp.float32).reshape(B, n, L, H, t.shape[-1]).transpose(1, 0, 3, 2, 4)

    def step(R, inp):
        qi, ki, vi = inp
        s = jnp.einsum('bhid,bhjd->bhij', qi, ki) * decay_in[None]
        o = (jnp.einsum('bhij,bhjv->bhiv', s, vi)
             + jnp.einsum('bhid,bhdv->bhiv', qi, R) * decay_q[None, :, :, None])
        R = R * decay_blk[None, :, None, None] + jnp.einsum('bhjd,bhjv->bhdv', ki * decay_k[None, :, :, None], vi)
        return R, o

    R, o = lax.scan(step, state, (to_blocks(q), to_blocks(k), to_blocks(v)))
    o = o.transpose(1, 0, 3, 2, 4).reshape(B, S, H, v.shape[-1])
    return o, R


def memory_kv(mem, g_mem, w_mem_kv):
    B = mem.shape[0]
    kv = rms_norm(mem, g_mem) @ w_mem_kv
    k, v = jnp.split(kv, 2, axis=-1)
    return (k.reshape(B, MEM_LEN, MEM_HEADS, MEM_HEAD_DIM),
            v.reshape(B, MEM_LEN, MEM_HEADS, MEM_HEAD_DIM))


def mixer_layer(x, pos, ret_state, mem_k, mem_v, g_pre, w_in, g_anorm, w_s, b_s, g_ret,
                w_out_a, w_out_b, w_out_c, w_out):
    B, S, _ = x.shape
    h = rms_norm(x, g_pre)
    z = h @ w_in
    a_u, a_v, a_g, r_q, r_k, r_v, r_g, c_q, c_g, gates = jnp.split(z, np.cumsum(SPLITS)[:-1].tolist(), axis=-1)

    u = jax.nn.gelu(a_u)
    vn = layer_norm(jax.nn.gelu(a_v), g_anorm)
    y_a = (u * chunk_spatial(vn, w_s, b_s) * jax.nn.silu(a_g)) @ w_out_a

    q = rotary(r_q.reshape(B, S, RET_HEADS, RET_HEAD_DIM), pos)
    k = rotary(r_k.reshape(B, S, RET_HEADS, RET_HEAD_DIM), pos) * (RET_HEAD_DIM ** -0.5)
    v = r_v.reshape(B, S, RET_HEADS, RET_HEAD_DIM)
    o, R = retention(q, k, v, ret_state)
    mu = jnp.mean(o, axis=-1, keepdims=True)
    var = jnp.mean(jnp.square(o - mu), axis=-1, keepdims=True)
    o = (o - mu) * lax.rsqrt(var + EPS) * g_ret.astype(jnp.float32).reshape(RET_HEADS, RET_HEAD_DIM)
    y_b = (o.astype(x.dtype).reshape(B, S, RET_WIDTH) * jax.nn.silu(r_g)) @ w_out_b

    qm = c_q.reshape(B, S, MEM_HEADS, MEM_HEAD_DIM)
    sc = jnp.einsum('bshd,bmhd->bhsm', qm.astype(jnp.float32), mem_k.astype(jnp.float32)) * (MEM_HEAD_DIM ** -0.5)
    p = jax.nn.softmax(sc, axis=-1).astype(x.dtype)
    om = jnp.einsum('bhsm,bmhd->bshd', p, mem_v).reshape(B, S, MEM_WIDTH)
    y_c = (om * jax.nn.silu(c_g)) @ w_out_c

    gs = jax.nn.sigmoid(gates.astype(jnp.float32)).astype(x.dtype).reshape(B, S, N_BRANCH, D_MODEL)
    merged = gs[:, :, 0] * y_a + gs[:, :, 1] * y_b + gs[:, :, 2] * y_c
    return x + merged @ w_out, R.astype(ret_state.dtype), vn


def setup_inputs(seed: int = 0) -> dict:
    key = jax.random.key(seed)
    ks = jax.random.split(key, 24)
    f32 = jnp.float32
    nrm = lambda k, shape, s: jax.random.normal(k, shape, f32) * s
    return {
        "x_prompt": nrm(ks[0], (BATCH, SEQ, D_MODEL), 1.0),
        "x_sample": nrm(ks[1], (DEC_BATCH, DEC_SEQ, D_MODEL), 1.0),
        "state_ret": nrm(ks[2], (DEPTH, DEC_BATCH, RET_HEADS, RET_HEAD_DIM, RET_HEAD_DIM), RET_HEAD_DIM ** -0.5),
        "cache_mem_k": nrm(ks[3], (DEPTH, DEC_BATCH, MEM_LEN, MEM_HEADS, MEM_HEAD_DIM), 1.0),
        "cache_mem_v": nrm(ks[4], (DEPTH, DEC_BATCH, MEM_LEN, MEM_HEADS, MEM_HEAD_DIM), 1.0),
        "mem_prompt": nrm(ks[5], (BATCH, MEM_LEN, D_MODEL), 1.0),
        "g_pre": 1.0 + nrm(ks[6], (DEPTH, D_MODEL), 0.02),
        "w_in": nrm(ks[7], (DEPTH, D_MODEL, IN_WIDTH), D_MODEL ** -0.5),
        "g_anorm": 1.0 + nrm(ks[8], (DEPTH, A_WIDTH), 0.02),
        "w_s": nrm(ks[9], (DEPTH, A_GROUPS, CHUNK, CHUNK), 0.5 * CHUNK ** -0.5),
        "b_s": 1.0 + nrm(ks[10], (DEPTH, A_GROUPS, CHUNK), 0.02),
        "g_ret": 1.0 + nrm(ks[11], (DEPTH, RET_WIDTH), 0.02),
        "g_mem": 1.0 + nrm(ks[12], (DEPTH, D_MODEL), 0.02),
        "w_mem_kv": nrm(ks[13], (DEPTH, D_MODEL, 2 * MEM_WIDTH), D_MODEL ** -0.5),
        "w_out_a": nrm(ks[14], (DEPTH, A_WIDTH, D_MODEL), A_WIDTH ** -0.5),
        "w_out_b": nrm(ks[15], (DEPTH, RET_WIDTH, D_MODEL), RET_WIDTH ** -0.5),
        "w_out_c": nrm(ks[16], (DEPTH, MEM_WIDTH, D_MODEL), MEM_WIDTH ** -0.5),
        "w_out": nrm(ks[17], (DEPTH, D_MODEL, D_MODEL), 0.5 * D_MODEL ** -0.5),
        "g_final": 1.0 + nrm(ks[18], (D_MODEL,), 0.02),
    }


def reference(x_prompt, x_sample, state_ret, cache_mem_k, cache_mem_v, mem_prompt,
              g_pre, w_in, g_anorm, w_s, b_s, g_ret, g_mem, w_mem_kv,
              w_out_a, w_out_b, w_out_c, w_out, g_final):
    pos_p = jnp.arange(SEQ, dtype=jnp.int32)
    pos_s = PAST_LEN + jnp.arange(DEC_SEQ, dtype=jnp.int32)
    xp, xs = x_prompt, x_sample
    ret_p_all, mk_all, mv_all, ret_s_all, vs_all = [], [], [], [], []
    for l in range(DEPTH):
        shared = (g_pre[l], w_in[l], g_anorm[l], w_s[l], b_s[l], g_ret[l],
                  w_out_a[l], w_out_b[l], w_out_c[l], w_out[l])
        mk, mv = memory_kv(mem_prompt, g_mem[l], w_mem_kv[l])
        zero_state = jnp.zeros((BATCH, RET_HEADS, RET_HEAD_DIM, RET_HEAD_DIM), jnp.float32)
        xp, ret_p, _ = mixer_layer(xp, pos_p, zero_state, mk, mv, *shared)
        xs, ret_s, v_s = mixer_layer(xs, pos_s, state_ret[l], cache_mem_k[l], cache_mem_v[l], *shared)
        ret_p_all.append(ret_p)
        mk_all.append(mk)
        mv_all.append(mv)
        ret_s_all.append(ret_s)
        vs_all.append(v_s)
    y_prompt = rms_norm(xp, g_final)
    y_sample = rms_norm(xs, g_final)
    return (y_prompt, y_sample, jnp.stack(ret_p_all), jnp.stack(mk_all), jnp.stack(mv_all),
            jnp.stack(ret_s_all), jnp.stack(vs_all))
```

```cpp
#include <hip/hip_runtime.h>
#include <cstdio>
#include <cstdint>

#ifndef MK_N_LAUNCHES
#define MK_N_LAUNCHES 1
#endif

#define LAS __attribute__((address_space(3)))
#define GAS __attribute__((address_space(1)))
typedef unsigned short bf16_t;
typedef short bf16x8 __attribute__((ext_vector_type(8)));
typedef short s16x4 __attribute__((ext_vector_type(4)));
typedef float f32x4 __attribute__((ext_vector_type(4)));
typedef float f32x2 __attribute__((ext_vector_type(2)));
typedef unsigned u32x4 __attribute__((ext_vector_type(4)));
typedef unsigned u32x2 __attribute__((ext_vector_type(2)));
typedef GAS unsigned gu32;

constexpr int D = 4096, MP = 8192, MS = 128, MREAL = MP + MS, MPAD = 8448;
constexpr int NIN = 28672, LDZ = NIN, AW = 2048, RW = 2048, MW = 1024;
constexpr int ZC_U = 0, ZC_V = 2048, ZC_G = 4096, ZC_Q = 6144, ZC_K = 8192, ZC_RV = 10240, ZC_RG = 12288, ZC_CQ = 14336, ZC_CG = 15360, ZC_GS = 16384;
constexpr float EPS = 1e-6f;
constexpr size_t O_YP = 0, O_YS = 33554432, O_RP = 34078720, O_MK = 36175872, O_MV = 37224448, O_RS = 38273024, O_GV = 105381888, O_END = 105644032;

constexpr size_t MiB = 1u << 20;
constexpr size_t WS_CTL = 0, CTL_ZERO_BYTES = 64 * 1024;
constexpr size_t WS_ROPE = 1 * MiB;
constexpr size_t WS_STATV = 4 * MiB;
constexpr size_t WS_STATO = 7 * MiB;
constexpr size_t WS_STATS = 10 * MiB;
constexpr size_t WS_WIN = 16 * MiB;
constexpr size_t WS_WMEM = 240 * MiB;
constexpr size_t WS_WOA = 256 * MiB;
constexpr size_t WS_WOB = 272 * MiB;
constexpr size_t WS_WOC = 288 * MiB;
constexpr size_t WS_WOUT = 296 * MiB;
constexpr size_t WS_H = 328 * MiB;
constexpr size_t WS_MEMN = 394 * MiB;
constexpr size_t WS_Z = 402 * MiB;
constexpr size_t WS_MKV = 864 * MiB;
constexpr size_t WS_RS = 868 * MiB;
constexpr size_t WS_AACT = 928 * MiB;
constexpr size_t WS_BACT = 961 * MiB;
constexpr size_t WS_CACT = 994 * MiB;
constexpr size_t WS_MG = 1012 * MiB;
constexpr size_t WS_END = 1078 * MiB;
static_assert(WS_WIN + (size_t)NIN * D * 2 <= WS_WMEM && WS_H + (size_t)MPAD * D * 2 <= WS_MEMN && WS_Z + (size_t)MPAD * LDZ * 2 <= WS_MKV, "ws map");
static_assert(WS_RS + (size_t)480 * 65536 * 2 <= WS_AACT && WS_AACT + (size_t)MPAD * AW * 2 <= WS_BACT && WS_CACT + (size_t)MPAD * MW * 2 <= WS_MG && WS_MG + (size_t)MPAD * D * 2 <= WS_END, "ws map 2");
constexpr int CW_BAR = 1024;

constexpr int RING_BYTES = 131072;
constexpr int IMG_PITCH = 528;
constexpr int SMALL_OFF = 135168;
constexpr int MISC_OFF = 151552;
constexpr int LDS_BYTES = 155648;

#define LDS_WAIT() asm volatile("s_waitcnt lgkmcnt(0)" ::: "memory")
#define VM_WAIT() asm volatile("s_waitcnt vmcnt(0)" ::: "memory")

namespace pg8 {
constexpr int BM = 256, BK = 64, HALF = 128, HTB = HALF * BK * 2, STAGE_BYTES = 8 * HTB, NXCD = 8, WGM = 8;
__host__ __device__ __forceinline__ int lds_byte(int r, int c) { const int st = (r >> 4) * 2 + (c >> 5), rr = r & 15, cc = c & 31, ob = rr * 64 + cc * 2; return st * 1024 + (ob ^ (((ob >> 9) & 1) << 5)); }
__host__ __device__ __forceinline__ void stage_rc(int b, int& R, int& C) { const int st = b / 1024, sb = b % 1024, swz = sb ^ (((sb >> 9) & 1) << 5); R = (st >> 1) * 16 + swz / 64; C = (st & 1) * 32 + (swz % 64) / 2; }
__host__ __device__ __forceinline__ int perm32(int rho) { const int n = rho >> 4, i = rho & 15; return 8 * (i >> 2) + 4 * n + (i & 3); }

struct Unit { int pm, pn, kind; };

struct Order {
    const bf16_t *A0, *B0, *A1, *B1; int nM, nN, nwg, nX, nXn, G, c;
    __device__ __forceinline__ void init(const bf16_t* a0, const bf16_t* b0, int M, int N, int G_, int c_) { A0 = a0; B0 = b0; A1 = a0; B1 = b0; nM = M / BM; nN = N / BM; nwg = nM * nN; nX = 0; nXn = 1; G = G_; c = c_; }
    __device__ __forceinline__ bool next(int i, Unit& u) const {
        const long L = (long)i * G + c; const bool ok = L < nwg + nX; const bool ex = L >= nwg;
        const int r = (int)L - nwg;
        int wgid = ex ? 0 : (int)L; { const int q = nwg / NXCD, rr = nwg % NXCD, xcd = wgid % NXCD, off = wgid / NXCD; wgid = (xcd < rr ? xcd * (q + 1) : rr * (q + 1) + (xcd - rr) * q) + off; }
        const int nig = WGM * nN, gid = wgid / nig, fm = gid * WGM, gsz = (nM - fm) < WGM ? (nM - fm) : WGM;
        const int pm0 = fm + ((wgid % nig) % gsz), pn0 = (wgid % nig) / gsz;
        const int pm = ex ? r / nXn : pm0, pn = ex ? r % nXn : pn0;
        u.pm = pm; u.pn = pn; u.kind = ex ? 1 : 0; return ok;
    }
    __device__ __forceinline__ void operands(const Unit& u, size_t tstep, const char*& a, const char*& b) const {
        a = (const char*)(u.kind ? A1 : A0) + (size_t)u.pm * tstep; b = (const char*)(u.kind ? B1 : B0) + (size_t)u.pn * tstep; }
};

typedef float cvf32x2_t __attribute__((ext_vector_type(2))); typedef __bf16 cvbf16x2_t __attribute__((ext_vector_type(2)));
__device__ __forceinline__ unsigned cvt_pk_bf16(float lo, float hi) { cvf32x2_t v = {lo, hi}; cvbf16x2_t b = __builtin_convertvector(v, cvbf16x2_t); return __builtin_bit_cast(unsigned, b); }

template <class Epi, class Sched, bool IMG = false, bool ALIGN_EPI = true, bool SP2 = true>
__device__ __forceinline__ void gemm_phase(LAS unsigned char* lds, const int K, const Sched& S, const Epi& E) {
    const int tid = threadIdx.x, wid = __builtin_amdgcn_readfirstlane(tid >> 6), lane = tid & 63, wr = wid >> 2, wc = wid & 3, fr = lane & 15, fq = lane >> 4;
    const int nt = K / BK;
    unsigned voffA[2], voffB[2];
#pragma unroll
    for (int i = 0; i < 2; ++i) { int R, C; stage_rc(tid * 16 + i * 8192, R, C); const int Rb = Epi::PERM ? ((R & ~31) + perm32(R & 31)) : R;
        voffA[i] = (unsigned)(R * K + C) * 2u; voffB[i] = (unsigned)(Rb * K + C) * 2u;
        if (IMG) { voffA[i] = (unsigned)(tid * 16 + i * 8192); voffB[i] = voffA[i]; } }
    const size_t kstep = IMG ? (size_t)HTB : (size_t)(BK * 2);
    const size_t hstep = (size_t)HALF * K * 2;
    const size_t tstep = 2 * hstep;
    const unsigned ldsw = (unsigned)wid * 1024u;
    const int aoff = lds_byte(wr * 64 + fr, fq * 8), boff = lds_byte(wc * 32 + fr, fq * 8);
#define PG8_SA(b, h) (((b) * 2 + (h)) * HTB)
#define PG8_SB(b, h) ((4 + (b) * 2 + (h)) * HTB)
#define PG8_STAGE(bufoff, gbase, voff) do { _Pragma("unroll") for (int _i = 0; _i < 2; ++_i) \
        __builtin_amdgcn_global_load_lds((const unsigned*)((const char*)(gbase) + (voff)[_i]), (LAS unsigned*)(lds + (bufoff) + ldsw + _i * 8192), 16, 0, 0); } while (0)
#define PG8_LDA(dst, b, h) do { _Pragma("unroll") for (int m = 0; m < 4; ++m) _Pragma("unroll") for (int k = 0; k < 2; ++k) dst[m][k] = *(const LAS bf16x8*)(lds + PG8_SA(b, h) + aoff + m * 2048 + k * 1024); } while (0)
#define PG8_LDB(dst, b, h) do { _Pragma("unroll") for (int n = 0; n < 2; ++n) _Pragma("unroll") for (int k = 0; k < 2; ++k) dst[n][k] = *(const LAS bf16x8*)(lds + PG8_SB(b, h) + boff + n * 2048 + k * 1024); } while (0)
#define PG8_MMA(ai, bj, At, Bt) do { __builtin_amdgcn_s_setprio(1); _Pragma("unroll") for (int m = 0; m < 4; ++m) _Pragma("unroll") for (int n = 0; n < 2; ++n) _Pragma("unroll") for (int k = 0; k < 2; ++k) \
        acc[ai][bj][m][n] = __builtin_amdgcn_mfma_f32_16x16x32_bf16(Bt[n][k], At[m][k], acc[ai][bj][m][n], 0, 0, 0); __builtin_amdgcn_s_setprio(0); } while (0)
#define PG8_WAIT_V(n) asm volatile("s_waitcnt vmcnt(" #n ")" ::: "memory")
#define PG8_WAIT_L(n) asm volatile("s_waitcnt lgkmcnt(" #n ")" ::: "memory")
#define PG8_BAR __builtin_amdgcn_s_barrier()
#define PG8_SCHED __builtin_amdgcn_sched_barrier(0)
    Unit cur, nxt; int ui = 0;
    if (!S.next(0, cur)) return;
    f32x4 acc[2][2][4][2];
#pragma unroll
    for (int a = 0; a < 2; ++a)
#pragma unroll
        for (int b = 0; b < 2; ++b)
#pragma unroll
            for (int m = 0; m < 4; ++m)
#pragma unroll
                for (int n = 0; n < 2; ++n) acc[a][b][m][n] = (f32x4){0.f, 0.f, 0.f, 0.f};
    bf16x8 At[4][2], B0[2][2], B1[2][2];
    const char* cA; const char* cB; S.operands(cur, tstep, cA, cB);
    if constexpr (SP2) {
        PG8_STAGE(PG8_SB(0, 0), cB, voffB); PG8_STAGE(PG8_SB(0, 1), cB + hstep, voffB); PG8_STAGE(PG8_SA(0, 0), cA, voffA); PG8_STAGE(PG8_SA(0, 1), cA + hstep, voffA);
        if (wr == 1) PG8_BAR;
        PG8_WAIT_V(2); PG8_BAR;
        PG8_STAGE(PG8_SB(1, 0), cB + kstep, voffB); PG8_STAGE(PG8_SA(1, 0), cA + kstep, voffA); PG8_STAGE(PG8_SB(1, 1), cB + hstep + kstep, voffB);
        PG8_WAIT_V(6); PG8_BAR;
    } else {
        PG8_STAGE(PG8_SB(0, 0), cB, voffB); PG8_STAGE(PG8_SA(0, 0), cA, voffA); PG8_STAGE(PG8_SB(0, 1), cB + hstep, voffB); PG8_STAGE(PG8_SA(0, 1), cA + hstep, voffA);
        if (wr == 1) PG8_BAR;
        PG8_WAIT_V(4); PG8_BAR;
        PG8_STAGE(PG8_SB(1, 0), cB + kstep, voffB); PG8_STAGE(PG8_SA(1, 0), cA + kstep, voffA); PG8_STAGE(PG8_SB(1, 1), cB + hstep + kstep, voffB);
        PG8_WAIT_V(6); PG8_BAR;
    }
    for (;;) {
        const bool has_next = S.next(ui + 1, nxt);
        const char* nA = cA; const char* nB = cB; if (has_next) S.operands(nxt, tstep, nA, nB);
        for (int t = 0; t < nt; t += 2) {
            const bool last = (t == nt - 2);
            const char* a1 = cA + (size_t)(t + 1) * kstep;
            const char* a2 = last ? nA : cA + (size_t)(t + 2) * kstep; const char* b2 = last ? nB : cB + (size_t)(t + 2) * kstep;
            const char* a3 = a2 + kstep; const char* b3 = b2 + kstep;
            if constexpr (SP2) {
            PG8_LDB(B0, 0, 0); PG8_LDB(B1, 0, 1); PG8_SCHED; PG8_LDA(At, 0, 0); PG8_STAGE(PG8_SA(1, 1), a1 + hstep, voffA);
            PG8_WAIT_V(8); PG8_WAIT_L(0); PG8_BAR; PG8_MMA(0, 0, At, B0); PG8_MMA(0, 1, At, B1); PG8_BAR; PG8_SCHED;
            PG8_LDA(At, 0, 1); PG8_STAGE(PG8_SB(0, 0), b2, voffB); PG8_STAGE(PG8_SB(0, 1), b2 + hstep, voffB); PG8_STAGE(PG8_SA(0, 0), a2, voffA);
            PG8_WAIT_V(8); PG8_WAIT_L(0); PG8_BAR; PG8_MMA(1, 0, At, B0); PG8_MMA(1, 1, At, B1); PG8_BAR; PG8_SCHED;
            PG8_LDB(B0, 1, 0); PG8_LDB(B1, 1, 1); PG8_SCHED; PG8_LDA(At, 1, 0); PG8_STAGE(PG8_SA(0, 1), a2 + hstep, voffA);
            PG8_WAIT_V(8); PG8_WAIT_L(0); PG8_BAR; PG8_MMA(0, 0, At, B0); PG8_MMA(0, 1, At, B1); PG8_BAR; PG8_SCHED;
            PG8_LDA(At, 1, 1); PG8_STAGE(PG8_SB(1, 0), b3, voffB); PG8_STAGE(PG8_SB(1, 1), b3 + hstep, voffB); PG8_STAGE(PG8_SA(1, 0), a3, voffA);
            PG8_WAIT_V(8); PG8_WAIT_L(0); PG8_BAR; PG8_MMA(1, 0, At, B0); PG8_MMA(1, 1, At, B1); PG8_BAR; PG8_SCHED;
            } else {
            PG8_LDB(B0, 0, 0); PG8_SCHED; PG8_LDA(At, 0, 0); PG8_STAGE(PG8_SA(1, 1), a1 + hstep, voffA);
            PG8_WAIT_L(8); PG8_BAR; PG8_WAIT_L(0); PG8_MMA(0, 0, At, B0); PG8_BAR; PG8_SCHED;
            PG8_LDB(B1, 0, 1); PG8_STAGE(PG8_SB(0, 0), b2, voffB);
            PG8_BAR; PG8_WAIT_L(0); PG8_MMA(0, 1, At, B1); PG8_BAR;
            PG8_LDA(At, 0, 1); PG8_STAGE(PG8_SA(0, 0), a2, voffA);
            PG8_BAR; PG8_WAIT_L(0); PG8_MMA(1, 0, At, B0); PG8_BAR; PG8_SCHED;
            PG8_STAGE(PG8_SB(0, 1), b2 + hstep, voffB);
            PG8_WAIT_V(6); PG8_BAR; PG8_MMA(1, 1, At, B1); PG8_BAR;
            PG8_LDB(B0, 1, 0); PG8_SCHED; PG8_LDA(At, 1, 0); PG8_STAGE(PG8_SA(0, 1), a2 + hstep, voffA);
            PG8_WAIT_L(8); PG8_BAR; PG8_WAIT_L(0); PG8_MMA(0, 0, At, B0); PG8_BAR; PG8_SCHED;
            PG8_LDB(B1, 1, 1); PG8_STAGE(PG8_SB(1, 0), b3, voffB);
            PG8_BAR; PG8_WAIT_L(0); PG8_MMA(0, 1, At, B1); PG8_BAR;
            PG8_LDA(At, 1, 1); PG8_STAGE(PG8_SA(1, 0), a3, voffA);
            PG8_BAR; PG8_WAIT_L(0); PG8_MMA(1, 0, At, B0); PG8_BAR; PG8_SCHED;
            PG8_STAGE(PG8_SB(1, 1), b3 + hstep, voffB);
            PG8_WAIT_V(6); PG8_BAR; PG8_MMA(1, 1, At, B1); PG8_BAR;
            }
        }
        if constexpr (ALIGN_EPI) { if (wr == 0) PG8_BAR; }
        E(acc, cur, wr, wc, fr, fq);
        if (!has_next) break;
#pragma unroll
        for (int a = 0; a < 2; ++a)
#pragma unroll
            for (int b = 0; b < 2; ++b)
#pragma unroll
                for (int m = 0; m < 4; ++m)
#pragma unroll
                    for (int n = 0; n < 2; ++n) acc[a][b][m][n] = (f32x4){0.f, 0.f, 0.f, 0.f};
        cur = nxt; cA = nA; cB = nB; ++ui;
        if constexpr (ALIGN_EPI) { if (wr == 1) PG8_BAR; }
    }
    PG8_WAIT_V(0);
    if constexpr (!ALIGN_EPI) { if (wr == 0) PG8_BAR; }
    PG8_BAR;
#undef PG8_SA
#undef PG8_SB
#undef PG8_STAGE
#undef PG8_LDA
#undef PG8_LDB
#undef PG8_MMA
#undef PG8_WAIT_V
#undef PG8_WAIT_L
#undef PG8_BAR
#undef PG8_SCHED
}
}


__device__ __forceinline__ size_t img_off(int row, int k, int K) { return ((size_t)(row >> 7) * (size_t)(K >> 6) + (size_t)(k >> 6)) * 16384u + (size_t)pg8::lds_byte(row & 127, k & 63); }
__device__ __forceinline__ int perm_slot(int n) { const int s = n & 31; return (n & ~31) + 16 * ((s >> 2) & 1) + 4 * (s >> 3) + (s & 3); }
__device__ __forceinline__ unsigned pk2(float lo, float hi) { return pg8::cvt_pk_bf16(lo, hi); }
__device__ __forceinline__ float bflo(unsigned u) { return __uint_as_float(u << 16); }
__device__ __forceinline__ float bfhi(unsigned u) { return __uint_as_float(u & 0xffff0000u); }
__device__ __forceinline__ float bf1(bf16_t b) { return __uint_as_float(((unsigned)b) << 16); }
__device__ __forceinline__ f32x4 unpk4(u32x2 w) { return (f32x4){bflo(w.x), bfhi(w.x), bflo(w.y), bfhi(w.y)}; }
__device__ __forceinline__ u32x2 pack4(f32x4 v) { u32x2 w; w.x = pk2(v[0], v[1]); w.y = pk2(v[2], v[3]); return w; }
__device__ __forceinline__ float wave_sum(float v) {
#pragma unroll
    for (int o = 1; o < 64; o <<= 1) v += __shfl_xor(v, o);
    return v;
}
__device__ __forceinline__ float wave_max(float v) {
#pragma unroll
    for (int o = 1; o < 64; o <<= 1) v = fmaxf(v, __shfl_xor(v, o));
    return v;
}
__device__ __forceinline__ float ex2(float x) { return __builtin_amdgcn_exp2f(x); }
__device__ __forceinline__ float rcp(float x) { return __builtin_amdgcn_rcpf(x); }
__device__ __forceinline__ float sigm(float x) { return rcp(1.0f + ex2(-1.4426950408889634f * x)); }
__device__ __forceinline__ float silu(float x) { return x * sigm(x); }
__device__ __forceinline__ float gelu_t(float x) { const float u = x * (1.0f + 0.044715f * x * x); return x * rcp(1.0f + ex2(-2.3022081982f * u)); }
__device__ __forceinline__ float dot4(f32x4 a, f32x4 b) { return (a[0] * b[0] + a[1] * b[1]) + (a[2] * b[2] + a[3] * b[3]); }
__device__ __forceinline__ float hsum4(f32x4 a) { return (a[0] + a[1]) + (a[2] + a[3]); }
__device__ __forceinline__ float log2gamma(int h) { return log2f(1.0f - exp2f(-5.0f - (float)h)); }

__device__ __forceinline__ int launder(int v) { asm volatile("" : "+v"(v)); return v; }
__device__ __forceinline__ bf16x8 tr_frag(LAS const unsigned char* img, int pitch, int k0, int c0, int lane) {
    const int g = lane >> 4, q = (lane & 15) >> 2, p = lane & 3;
    LAS const unsigned char* a = img + (k0 + 8 * g + q) * pitch + (c0 + 4 * p) * 2;
    const s16x4 lo = __builtin_amdgcn_ds_read_tr16_b64_v4i16((LAS s16x4*)a);
    const s16x4 hi = __builtin_amdgcn_ds_read_tr16_b64_v4i16((LAS s16x4*)(a + 4 * pitch));
    return (bf16x8){lo[0], lo[1], lo[2], lo[3], hi[0], hi[1], hi[2], hi[3]};
}
__device__ __forceinline__ f32x4 mma(f32x4 acc, bf16x8 fcols, bf16x8 frows) { return __builtin_amdgcn_mfma_f32_16x16x32_bf16(fcols, frows, acc, 0, 0, 0); }

#define XB_TMO      128
#define XB_XCNT(j)  (256  + 64 * (j))
#define XB_XSUB(j)  (1280 + 64 * (j))
#define XB_XGEN(j)  (2304 + 64 * (j))
#define XB_TOP      3328
#define XB_TOPGEN   3392
#define XCD_BAR_WORDS 3456
#define XB_SPIN_CAP (1u << 22)
__device__ __forceinline__ unsigned xb_ld(unsigned* p)              { return __hip_atomic_load(p, __ATOMIC_RELAXED, __HIP_MEMORY_SCOPE_AGENT); }
__device__ __forceinline__ unsigned xb_add(unsigned* p, unsigned v) { return __hip_atomic_fetch_add(p, v, __ATOMIC_RELAXED, __HIP_MEMORY_SCOPE_AGENT); }
__device__ __forceinline__ unsigned xb_xcc_id() { return (unsigned)__builtin_amdgcn_s_getreg((3 << 11) | 20) & 0xFu; }
#define XB_SPIN(cond, bar) do { unsigned _sp = 0; while (cond) { __builtin_amdgcn_s_sleep(1); \
    if ((++_sp & 255u) == 0u) { if (xb_ld(&(bar)[XB_TMO])) break; if (_sp > XB_SPIN_CAP) { atomicAdd(&(bar)[XB_TMO], 1u); break; } } } } while (0)
struct XcdBarrier { unsigned* bar; unsigned x; volatile LAS unsigned* st; };
__device__ __forceinline__ XcdBarrier xcd_barrier_post(unsigned* bar, volatile LAS unsigned* st) {
    XcdBarrier b; b.bar = bar; b.x = xb_xcc_id(); b.st = st;
    if (threadIdx.x == 0) (void)xb_add(&bar[XB_XCNT(b.x)], 1u);
    return b;
}
__device__ __forceinline__ void xcd_barrier_complete(unsigned* bar, unsigned x, unsigned& nloc, unsigned& nx) {
    const unsigned G = gridDim.x * gridDim.y * gridDim.z;
    unsigned sum, cnt, mine, sp = 0u;
    for (;;) {
        sum = 0u; cnt = 0u; mine = 0u;
#pragma unroll
        for (unsigned j = 0; j < 16; ++j) { const unsigned c = xb_ld(&bar[XB_XCNT(j)]); sum += c; cnt += (c > 0u) ? 1u : 0u; mine = (j == x) ? c : mine; }
        if (sum == G) break;
        __builtin_amdgcn_s_sleep(1);
        if ((++sp & 255u) == 0u) { if (xb_ld(&bar[XB_TMO])) break; if (sp > XB_SPIN_CAP) { atomicAdd(&bar[XB_TMO], 1u); break; } }
    }
    nloc = mine > 0u ? mine : 1u; nx = cnt > 0u ? cnt : 1u;
}
__device__ __forceinline__ void xcd_barrier(const XcdBarrier& b) {
    asm volatile("s_waitcnt vmcnt(0)" ::: "memory");
    __syncthreads();
    if (threadIdx.x == 0) {
        unsigned* bar = b.bar;
        __builtin_amdgcn_s_waitcnt(0);
        unsigned nloc = b.st[0], nx = b.st[1];
        if (nloc == 0u) { xcd_barrier_complete(bar, b.x, nloc, nx); b.st[0] = nloc; b.st[1] = nx; }
        const unsigned old = xb_add(&bar[XB_XSUB(b.x)], 1u);
        const unsigned gen = old / nloc;
        if (old + 1u == (gen + 1u) * nloc) {
            __builtin_amdgcn_fence(__ATOMIC_RELEASE, "agent");
            asm volatile("s_waitcnt vmcnt(0)" ::: "memory");
            const unsigned og = xb_add(&bar[XB_TOP], 1u);
            const unsigned tg = og / nx;
            if (og + 1u == (tg + 1u) * nx) xb_add(&bar[XB_TOPGEN], 1u);
            else XB_SPIN(xb_ld(&bar[XB_TOPGEN]) == tg, bar);
            __builtin_amdgcn_fence(__ATOMIC_ACQUIRE, "agent");
            xb_add(&bar[XB_XGEN(b.x)], 1u);
            asm volatile("s_waitcnt vmcnt(0)" ::: "memory");
        } else {
            XB_SPIN(xb_ld(&bar[XB_XGEN(b.x)]) == gen, bar);
            __builtin_amdgcn_fence(__ATOMIC_ACQUIRE, "agent");
            asm volatile("s_waitcnt vmcnt(0)" ::: "memory");
        }
    }
    __syncthreads();
}

struct Frame {
    LAS unsigned char* lds;
    int tid, lane, wave, G, cu;
    const float *xp, *xs, *state, *cmk, *cmv, *memp, *g_pre, *w_in, *g_anorm, *w_s, *b_s, *g_ret, *g_mem, *w_mem, *w_oa, *w_ob, *w_oc, *w_out, *g_final;
    float* out; unsigned char* ws;
    bf16_t *WinT, *WmemT, *WoaT, *WobT, *WocT, *WoutT, *H, *MEMN, *Z, *MKV, *RS, *AACT, *BACT, *CACT, *MG;
    float *ropec, *ropes, *statv, *stato, *stats;
};

struct EpiZ {
    static constexpr bool PERM = true;
    bf16_t* Z; float* statv; const float* ropec; const float* ropes; float* omk; float* omv; bf16_t* mkv;
    template <int ACT> __device__ __forceinline__ void ew(const f32x4 (&acc)[2][2][4][2], int pn, int row0, int wc, int fq) const {
        bf16_t* zb = Z + (size_t)pn * 256 + wc * 32 + 8 * fq;
#pragma unroll
        for (int ai = 0; ai < 2; ++ai)
#pragma unroll
            for (int m = 0; m < 4; ++m) { const size_t row = (size_t)(row0 + ai * 128 + m * 16); float s = 0.f, q = 0.f;
#pragma unroll
                for (int bj = 0; bj < 2; ++bj) { f32x4 v0 = acc[ai][bj][m][0], v1 = acc[ai][bj][m][1];
#pragma unroll
                    for (int e = 0; e < 4; ++e) {
                        if (ACT == 1 || ACT == 2) { v0[e] = gelu_t(v0[e]); v1[e] = gelu_t(v1[e]); }
                        if (ACT == 3) { v0[e] = silu(v0[e]); v1[e] = silu(v1[e]); }
                        if (ACT == 4) { v0[e] = v0[e] * 0.0625f; v1[e] = v1[e] * 0.0625f; }
                        if (ACT == 5) { v0[e] = sigm(v0[e]); v1[e] = sigm(v1[e]); } }
                    if (ACT == 2) { s += hsum4(v0) + hsum4(v1); q += dot4(v0, v0) + dot4(v1, v1); }
                    u32x4 w; w.x = pk2(v0[0], v0[1]); w.y = pk2(v0[2], v0[3]); w.z = pk2(v1[0], v1[1]); w.w = pk2(v1[2], v1[3]);
                    *(u32x4*)(zb + row * LDZ + bj * 128) = w; }
                if (ACT == 2) { s += __shfl_xor(s, 16); s += __shfl_xor(s, 32); q += __shfl_xor(q, 16); q += __shfl_xor(q, 32);
                    if (fq == 0) *(f32x2*)(statv + (row * 32 + (pn - 8) * 4 + wc) * 2) = (f32x2){s, q}; } }
    }
    __device__ __forceinline__ void rot(const f32x4 (&acc)[2][2][4][2], int pn, int row0, int wc, int fq) const {
        const float sc = (pn >= 32) ? 0.0625f : 1.0f; bf16_t* zb = Z + (size_t)pn * 256 + wc * 32 + 8 * fq;
#pragma unroll
        for (int ai = 0; ai < 2; ++ai)
#pragma unroll
            for (int m = 0; m < 4; ++m) { const int row = row0 + ai * 128 + m * 16; const int p = row < MP ? (row & 2047) : 2048; const size_t ti = (size_t)p * 128 + wc * 32 + 8 * fq;
                const f32x4 c0 = *(const f32x4*)(ropec + ti) * sc, c1 = *(const f32x4*)(ropec + ti + 4) * sc, s0 = *(const f32x4*)(ropes + ti) * sc, s1 = *(const f32x4*)(ropes + ti + 4) * sc;
                const f32x4 a0 = acc[ai][0][m][0], a1 = acc[ai][0][m][1], b0 = acc[ai][1][m][0], b1 = acc[ai][1][m][1];
                const f32x4 x0 = a0 * c0 - b0 * s0, x1 = a1 * c1 - b1 * s1, y0 = a0 * s0 + b0 * c0, y1 = a1 * s1 + b1 * c1;
                u32x4 w; w.x = pk2(x0[0], x0[1]); w.y = pk2(x0[2], x0[3]); w.z = pk2(x1[0], x1[1]); w.w = pk2(x1[2], x1[3]);
                *(u32x4*)(zb + (size_t)row * LDZ) = w;
                w.x = pk2(y0[0], y0[1]); w.y = pk2(y0[2], y0[3]); w.z = pk2(y1[0], y1[1]); w.w = pk2(y1[2], y1[3]);
                *(u32x4*)(zb + (size_t)row * LDZ + 128) = w;
                asm volatile("" ::: "memory"); }
    }
    __device__ __forceinline__ void operator()(f32x4 (&acc)[2][2][4][2], const pg8::Unit& u, int wr, int wc, int fr, int fq) const {
        const int row0 = u.pm * 256 + wr * 64 + fr;
        if (u.kind == 1) {
            const int colt = u.pn * 256 + wc * 32 + 8 * fq; float* ob = (u.pn < 4) ? omk : omv; const int cc = colt & 1023;
#pragma unroll
            for (int ai = 0; ai < 2; ++ai)
#pragma unroll
                for (int m = 0; m < 4; ++m) { const size_t row = (size_t)(row0 + ai * 128 + m * 16);
#pragma unroll
                    for (int bj = 0; bj < 2; ++bj) { const f32x4 v0 = acc[ai][bj][m][0], v1 = acc[ai][bj][m][1];
                        *(f32x4*)(ob + row * 1024 + cc + bj * 128) = v0; *(f32x4*)(ob + row * 1024 + cc + bj * 128 + 4) = v1;
                        u32x4 w; w.x = pk2(v0[0], v0[1]); w.y = pk2(v0[2], v0[3]); w.z = pk2(v1[0], v1[1]); w.w = pk2(v1[2], v1[3]);
                        *(u32x4*)(mkv + row * 2048 + colt + bj * 128) = w; } }
            return;
        }
        const int pn = u.pn;
        if (pn < 8) ew<1>(acc, pn, row0, wc, fq);
        else if (pn < 16) ew<2>(acc, pn, row0, wc, fq);
        else if (pn < 24 || (pn >= 48 && pn < 56) || (pn >= 60 && pn < 64)) ew<3>(acc, pn, row0, wc, fq);
        else if (pn < 40) rot(acc, pn, row0, wc, fq);
        else if (pn < 48) ew<0>(acc, pn, row0, wc, fq);
        else if (pn < 60) ew<4>(acc, pn, row0, wc, fq);
        else ew<5>(acc, pn, row0, wc, fq);
    }
};
struct EpiMerge {
    static constexpr bool PERM = true;
    const bf16_t* Z; bf16_t* MG; int pass;
    __device__ __forceinline__ void operator()(f32x4 (&acc)[2][2][4][2], const pg8::Unit& u, int wr, int wc, int fr, int fq) const {
        const int row0 = u.pm * 256 + wr * 64 + fr, col0 = u.pn * 256 + wc * 32 + 8 * fq;
#pragma unroll
        for (int ai = 0; ai < 2; ++ai)
#pragma unroll
            for (int m = 0; m < 4; ++m) { const size_t row = (size_t)(row0 + ai * 128 + m * 16);
#pragma unroll
                for (int bj = 0; bj < 2; ++bj) { const int c = col0 + bj * 128;
                    const u32x4 g = *(const u32x4*)(Z + row * LDZ + ZC_GS + pass * D + c);
                    f32x4 v0 = acc[ai][bj][m][0] * (f32x4){bflo(g.x), bfhi(g.x), bflo(g.y), bfhi(g.y)}, v1 = acc[ai][bj][m][1] * (f32x4){bflo(g.z), bfhi(g.z), bflo(g.w), bfhi(g.w)};
                    if (pass) { const u32x4 p = *(const u32x4*)(MG + row * D + c); v0 += (f32x4){bflo(p.x), bfhi(p.x), bflo(p.y), bfhi(p.y)}; v1 += (f32x4){bflo(p.z), bfhi(p.z), bflo(p.w), bfhi(p.w)}; }
                    u32x4 w; w.x = pk2(v0[0], v0[1]); w.y = pk2(v0[2], v0[3]); w.z = pk2(v1[0], v1[1]); w.w = pk2(v1[2], v1[3]);
                    *(u32x4*)(MG + row * D + c) = w; } }
    }
};
struct EpiOut {
    static constexpr bool PERM = false;
    const float* X; float* Y; float* stato;
    __device__ __forceinline__ void operator()(f32x4 (&acc)[2][2][4][2], const pg8::Unit& u, int wr, int wc, int fr, int fq) const {
        const int row0 = u.pm * 256 + wr * 64 + fr, col0 = u.pn * 256 + wc * 32 + 4 * fq;
#pragma unroll
        for (int ai = 0; ai < 2; ++ai)
#pragma unroll
            for (int m = 0; m < 4; ++m) { const size_t row = (size_t)(row0 + ai * 128 + m * 16); float q = 0.f;
#pragma unroll
                for (int bj = 0; bj < 2; ++bj)
#pragma unroll
                    for (int n = 0; n < 2; ++n) { const size_t o = row * D + col0 + bj * 128 + n * 16; const f32x4 v = *(const f32x4*)(X + o) + acc[ai][bj][m][n]; *(f32x4*)(Y + o) = v; q += dot4(v, v); }
                q += __shfl_xor(q, 16); q += __shfl_xor(q, 32);
                if (fq == 0) stato[row * 64 + u.pn * 4 + wc] = q; }
    }
};

template <int MODE> __device__ __forceinline__ void p0_transpose_item(const float* W, int K, int N, bf16_t* WT, LAS float* scr, int item, int lane) {
    const int nblk = N / 32, kb = item / nblk, nb = item % nblk, k0 = 64 * kb, n0 = 32 * nb;
    const float* src = W + (size_t)(k0 + (lane >> 5)) * N + n0 + (lane & 31);
    float v[32];
#pragma unroll
    for (int i = 0; i < 32; ++i) v[i] = __builtin_nontemporal_load(src + (size_t)(2 * i) * N);
#pragma unroll
    for (int i = 0; i < 32; ++i) scr[(2 * i + (lane >> 5)) * 33 + (lane & 31)] = v[i];
    LDS_WAIT();
    const int c = lane & 7;
#pragma unroll
    for (int j = 0; j < 4; ++j) { const int n = (lane >> 3) + 8 * j; const LAS float* s = scr + (8 * c) * 33 + n;
        u32x4 o; o.x = pk2(s[0 * 33], s[1 * 33]); o.y = pk2(s[2 * 33], s[3 * 33]); o.z = pk2(s[4 * 33], s[5 * 33]); o.w = pk2(s[6 * 33], s[7 * 33]);
        if (MODE == 0) *(u32x4*)(WT + (size_t)(n0 + n) * K + k0 + 8 * c) = o;
        else { const int nn = n0 + n; *(u32x4*)((unsigned char*)WT + img_off(MODE == 2 ? perm_slot(nn) : nn, k0 + 8 * c, K)) = o; } }
    LDS_WAIT();
}
__device__ __forceinline__ void rms_row_to_bf16(const float* xrow, const float* g, bf16_t* obase, int m, int lane) {
    const f32x4* xr = (const f32x4*)xrow + lane; f32x4 v[16]; float s = 0.f;
#pragma unroll
    for (int j = 0; j < 16; ++j) { v[j] = xr[64 * j]; s += dot4(v[j], v[j]); }
    const float r = 1.0f / sqrtf(wave_sum(s) * (1.0f / 4096.0f) + EPS);
    const f32x4* gr = (const f32x4*)g + lane;
#pragma unroll
    for (int j = 0; j < 16; ++j) { const f32x4 y = v[j] * r * gr[64 * j]; *(u32x2*)((unsigned char*)obase + img_off(m, 4 * lane + 256 * j, D)) = pack4(y); }
}
__device__ __forceinline__ void p0_prologue(const Frame& F) {
    LAS float* scr = (LAS float*)(F.lds + F.wave * 8448);
    const int gw = F.cu * 8 + F.wave, NGW = F.G * 8;
    constexpr int I_IN = (D / 64) * (NIN / 32), I_MEM = (D / 64) * (2048 / 32), I_OA = (AW / 64) * (D / 32), I_OB = (RW / 64) * (D / 32), I_OC = (MW / 64) * (D / 32), I_OUT = (D / 64) * (D / 32);
    constexpr int NITEMS = I_IN + I_MEM + I_OA + I_OB + I_OC + I_OUT;
    for (int it = gw; it < NITEMS; it += NGW) {
        int r = it;
        if (r < I_IN) { p0_transpose_item<2>(F.w_in, D, NIN, F.WinT, scr, r, F.lane); continue; } r -= I_IN;
        if (r < I_MEM) { p0_transpose_item<2>(F.w_mem, D, 2048, F.WmemT, scr, r, F.lane); continue; } r -= I_MEM;
        if (r < I_OA) { p0_transpose_item<0>(F.w_oa, AW, D, F.WoaT, scr, r, F.lane); continue; } r -= I_OA;
        if (r < I_OB) { p0_transpose_item<0>(F.w_ob, RW, D, F.WobT, scr, r, F.lane); continue; } r -= I_OB;
        if (r < I_OC) { p0_transpose_item<0>(F.w_oc, MW, D, F.WocT, scr, r, F.lane); continue; } r -= I_OC;
        p0_transpose_item<0>(F.w_out, D, D, F.WoutT, scr, r, F.lane);
    }
    for (int m = gw; m < MPAD + 1024; m += NGW) {
        if (m < MP) rms_row_to_bf16(F.xp + (size_t)m * D, F.g_pre, F.H, m, F.lane);
        else if (m < MREAL) rms_row_to_bf16(F.xs + (size_t)(m - MP) * D, F.g_pre, F.H, m, F.lane);
        else if (m < MPAD) { u32x4* o = (u32x4*)((unsigned char*)F.H + (size_t)(MREAL >> 7) * 64 * 16384 + (size_t)(m - MREAL) * 8192) + F.lane;
#pragma unroll
            for (int j = 0; j < 8; ++j) o[64 * j] = (u32x4){0u, 0u, 0u, 0u}; }
        else rms_row_to_bf16(F.memp + (size_t)(m - MPAD) * D, F.g_mem, F.MEMN, m - MPAD, F.lane);
    }
    for (int idx = F.cu * 512 + F.tid; idx < 2049 * 128; idx += F.G * 512) {
        const int p = idx >> 7, j = idx & 127; const int pos = p < 2048 ? p : 16384;
        double iv = 1.0, bs = 0.9305720409296989; for (int e = j; e > 0; e >>= 1) { if (e & 1) iv *= bs; bs *= bs; }
        const float inv = (float)iv; const float ang = (float)pos * inv;
        const double x = (double)ang; const double n = __builtin_rint(x * 0.15915494309189535);
        const double r = __builtin_fma(-n, 2.4492935982947064e-16, __builtin_fma(-n, 6.283185307179586, x)); const double r2 = r * r;
        double sn = r, tm = r, cs = 1.0, tc = 1.0;
#pragma unroll
        for (int k = 1; k <= 13; ++k) { tm *= -r2 * (1.0 / (double)((2 * k) * (2 * k + 1))); sn += tm; tc *= -r2 * (1.0 / (double)((2 * k - 1) * (2 * k))); cs += tc; }
        F.ropec[idx] = (float)cs; F.ropes[idx] = (float)sn;
    }
}

template <int NROWS>
__device__ __forceinline__ void stage_tile256(LAS unsigned char* img, const bf16_t* src, size_t ld, int tid) {
    constexpr int PER = NROWS * 32 / 512;
#pragma unroll
    for (int b0 = 0; b0 < PER; b0 += 8) {
        u32x4 v[8];
#pragma unroll
        for (int i = 0; i < 8; ++i) { const int ch = tid + 512 * (b0 + i), row = ch >> 5, cc = ch & 31; v[i] = *(const u32x4*)(src + (size_t)row * ld + cc * 8); }
#pragma unroll
        for (int i = 0; i < 8; ++i) { const int ch = tid + 512 * (b0 + i), row = ch >> 5, cc = ch & 31; *(LAS u32x4*)(img + row * IMG_PITCH + cc * 16) = v[i]; }
    }
}

__device__ __forceinline__ void scan_unit(const Frame& F, int b, int h, int sl) {
    LAS unsigned char* imgK = F.lds; LAS unsigned char* imgV = F.lds + 67584;
    const int w = F.wave, tid = launder(F.tid), lane = tid & 63, fr = lane & 15, fq = lane >> 4;
    const float l2g = log2gamma(h); const float dblk = ex2(128.0f * l2g);
    f32x4 acc[2][2];
#pragma unroll
    for (int a = 0; a < 2; ++a)
#pragma unroll
        for (int k = 0; k < 2; ++k) acc[a][k] = (f32x4){0.f, 0.f, 0.f, 0.f};
    for (int c = 0; c < 16; ++c) {
        const size_t r0 = (size_t)b * 2048 + c * 128;
        __syncthreads();
        stage_tile256<128>(imgK, F.Z + r0 * LDZ + ZC_K + h * 256, LDZ, tid);
        { const int j = tid >> 2, cc = tid & 3; const u32x4 raw = *(const u32x4*)(F.Z + (r0 + j) * LDZ + ZC_RV + h * 256 + sl * 32 + cc * 8);
          const float sc = ex2((float)(127 - j) * l2g);
          u32x4 o; o.x = pk2(bflo(raw.x) * sc, bfhi(raw.x) * sc); o.y = pk2(bflo(raw.y) * sc, bfhi(raw.y) * sc); o.z = pk2(bflo(raw.z) * sc, bfhi(raw.z) * sc); o.w = pk2(bflo(raw.w) * sc, bfhi(raw.w) * sc);
          *(LAS u32x4*)(imgV + j * 80 + cc * 16) = o; }
        __syncthreads();
#pragma unroll
        for (int a = 0; a < 2; ++a)
#pragma unroll
            for (int k = 0; k < 2; ++k) acc[a][k] = acc[a][k] * dblk;
#pragma unroll
        for (int s = 0; s < 4; ++s) {
            bf16x8 fv[2], fk[2];
#pragma unroll
            for (int a = 0; a < 2; ++a) { fv[a] = tr_frag(imgV, 80, 32 * s, 16 * a, lane); fk[a] = tr_frag(imgK, IMG_PITCH, 32 * s, 32 * w + 16 * a, lane); }
#pragma unroll
            for (int a = 0; a < 2; ++a)
#pragma unroll
                for (int k = 0; k < 2; ++k) acc[a][k] = mma(acc[a][k], fk[k], fv[a]);
        }
        if (c < 15) {
            bf16_t* rs = F.RS + ((size_t)(b * 8 + h) * 15 + c) * 65536;
#pragma unroll
            for (int a = 0; a < 2; ++a)
#pragma unroll
                for (int k = 0; k < 2; ++k) *(u32x2*)(rs + (size_t)(sl * 32 + 16 * a + fr) * 256 + 32 * w + 16 * k + 4 * fq) = pack4(acc[a][k]);
        }
    }
    float* rp = F.out + O_RP + (size_t)(b * 8 + h) * 65536;
#pragma unroll
    for (int a = 0; a < 2; ++a)
#pragma unroll
        for (int k = 0; k < 2; ++k)
#pragma unroll
            for (int e = 0; e < 4; ++e) rp[(size_t)(32 * w + 16 * k + 4 * fq + e) * 256 + sl * 32 + 16 * a + fr] = acc[a][k][e];
}

__device__ __forceinline__ void spatial_unit(const Frame& F, int b, int c, int g, int hf) {
    LAS unsigned char* img = F.lds; LAS float* st = (LAS float*)(F.lds + SMALL_OFF);
    const int w = F.wave, tid = launder(F.tid), lane = tid & 63, fr = lane & 15, fq = lane >> 4;
    const size_t r0 = (size_t)b * 2048 + c * 128; const int ch0 = g * 512 + hf * 256;
    __syncthreads();
    if (tid < 128) { const f32x4* p = (const f32x4*)(F.statv + (r0 + tid) * 64); float s = 0.f, q = 0.f;
#pragma unroll
        for (int k = 0; k < 16; ++k) { const f32x4 t = p[k]; s += t[0] + t[2]; q += t[1] + t[3]; }
        const float mu = s * (1.0f / 2048.0f); const float var = fmaxf(q * (1.0f / 2048.0f) - mu * mu, 0.f);
        st[2 * tid] = mu; st[2 * tid + 1] = 1.0f / sqrtf(var + EPS); }
    __syncthreads();
#pragma unroll
    for (int i = 0; i < 8; ++i) { const int chk = tid + 512 * i, row = chk >> 5, cc = chk & 31;
        const u32x4 raw = *(const u32x4*)(F.Z + (r0 + row) * LDZ + ZC_V + ch0 + cc * 8);
        const f32x4 ga = *(const f32x4*)(F.g_anorm + ch0 + cc * 8), gb = *(const f32x4*)(F.g_anorm + ch0 + cc * 8 + 4);
        const float mu = st[2 * row], rs = st[2 * row + 1];
        u32x4 o; o.x = pk2((bflo(raw.x) - mu) * rs * ga[0], (bfhi(raw.x) - mu) * rs * ga[1]); o.y = pk2((bflo(raw.y) - mu) * rs * ga[2], (bfhi(raw.y) - mu) * rs * ga[3]);
        o.z = pk2((bflo(raw.z) - mu) * rs * gb[0], (bfhi(raw.z) - mu) * rs * gb[1]); o.w = pk2((bflo(raw.w) - mu) * rs * gb[2], (bfhi(raw.w) - mu) * rs * gb[3]);
        *(LAS u32x4*)(img + row * IMG_PITCH + cc * 16) = o; }
    __syncthreads();
    const int i = 16 * w + fr;
    bf16x8 fw[4];
#pragma unroll
    for (int s = 0; s < 4; ++s) { const int j0 = 32 * s + 8 * fq; const float* wp = F.w_s + (size_t)g * 16384 + i * 128 + j0; const f32x4 a = *(const f32x4*)wp, bq = *(const f32x4*)(wp + 4);
        float t[8] = {a[0], a[1], a[2], a[3], bq[0], bq[1], bq[2], bq[3]};
#pragma unroll
        for (int e = 0; e < 8; ++e) t[e] = (j0 + e <= i) ? t[e] : 0.f;
        const unsigned p0 = pk2(t[0], t[1]), p1 = pk2(t[2], t[3]), p2 = pk2(t[4], t[5]), p3 = pk2(t[6], t[7]);
        const u32x4 pw = (u32x4){p0, p1, p2, p3}; fw[s] = __builtin_bit_cast(bf16x8, pw); }
    f32x4 acc[16];
#pragma unroll
    for (int n = 0; n < 16; ++n) acc[n] = (f32x4){0.f, 0.f, 0.f, 0.f};
    const int smax = w >> 1;
#pragma unroll
    for (int s = 0; s < 4; ++s) if (s <= smax) {
#pragma unroll
        for (int n = 0; n < 16; ++n) { acc[n] = mma(acc[n], tr_frag(img, IMG_PITCH, 32 * s, 16 * n, lane), fw[s]); if ((n & 3) == 3) __builtin_amdgcn_sched_barrier(0); }
    }
    const float bsv = F.b_s[g * 128 + i]; const bf16_t* zr = F.Z + (r0 + i) * LDZ; bf16_t* ar = F.AACT + (r0 + i) * AW;
#pragma unroll
    for (int n = 0; n < 16; ++n) { const int ch = ch0 + 16 * n + 4 * fq;
        const f32x4 uu = unpk4(*(const u32x2*)(zr + ZC_U + ch)), ag = unpk4(*(const u32x2*)(zr + ZC_G + ch));
        *(u32x2*)(ar + ch) = pack4(uu * (acc[n] + bsv) * ag); }
}
__device__ __forceinline__ void spatial_sample_row(const Frame& F, int s) {
    const int lane = launder(F.lane); const size_t row = (size_t)MP + s;
    float sm = 0.f, sq = 0.f; if (lane < 32) { const f32x2 t = *(const f32x2*)(F.statv + (row * 32 + lane) * 2); sm = t[0]; sq = t[1]; }
    sm = wave_sum(sm); sq = wave_sum(sq);
    const float mu = sm * (1.0f / 2048.0f); const float rs = 1.0f / sqrtf(fmaxf(sq * (1.0f / 2048.0f) - mu * mu, 0.f) + EPS);
    const bf16_t* zr = F.Z + row * LDZ;
#pragma unroll
    for (int g = 0; g < 4; ++g) { const int ch = g * 512 + lane * 8;
        const u32x4 rv = *(const u32x4*)(zr + ZC_V + ch), ru = *(const u32x4*)(zr + ZC_U + ch), rg = *(const u32x4*)(zr + ZC_G + ch);
        const f32x4 ga = *(const f32x4*)(F.g_anorm + ch), gb = *(const f32x4*)(F.g_anorm + ch + 4);
        const f32x4 v0 = ((f32x4){bflo(rv.x), bfhi(rv.x), bflo(rv.y), bfhi(rv.y)} - mu) * rs * ga, v1 = ((f32x4){bflo(rv.z), bfhi(rv.z), bflo(rv.w), bfhi(rv.w)} - mu) * rs * gb;
        *(f32x4*)(F.out + O_GV + (size_t)s * AW + ch) = v0; *(f32x4*)(F.out + O_GV + (size_t)s * AW + ch + 4) = v1;
        const float w00 = F.w_s[g * 16384], b0 = F.b_s[g * 128];
        const f32x4 a0 = (f32x4){bflo(ru.x), bfhi(ru.x), bflo(ru.y), bfhi(ru.y)} * (v0 * w00 + b0) * (f32x4){bflo(rg.x), bfhi(rg.x), bflo(rg.y), bfhi(rg.y)};
        const f32x4 a1 = (f32x4){bflo(ru.z), bfhi(ru.z), bflo(ru.w), bfhi(ru.w)} * (v1 * w00 + b0) * (f32x4){bflo(rg.z), bfhi(rg.z), bflo(rg.w), bfhi(rg.w)};
        u32x4 o; o.x = pk2(a0[0], a0[1]); o.y = pk2(a0[2], a0[3]); o.z = pk2(a1[0], a1[1]); o.w = pk2(a1[2], a1[3]);
        *(u32x4*)(F.AACT + row * AW + ch) = o; }
}
__device__ __forceinline__ void ret_sample_item(const Frame& F, int req, int h) {
    LAS float* qs = (LAS float*)F.lds; LAS float* ks = qs + 256; LAS float* red = qs + 512;
    const int w = F.wave, tid = launder(F.tid), lane = tid & 63; const size_t row = (size_t)MP + req; const bf16_t* zr = F.Z + row * LDZ;
    __syncthreads();
    if (tid < 256) { qs[tid] = bf1(zr[ZC_Q + h * 256 + tid]); ks[tid] = bf1(zr[ZC_K + h * 256 + tid]); }
    const f32x4 vv = unpk4(*(const u32x2*)(zr + ZC_RV + h * 256 + lane * 4));
    __syncthreads();
    const float gam = 1.0f - ex2(-5.0f - (float)h);
    const size_t base = ((size_t)(req * 8 + h) * 256) * 256 + lane * 4; const float* sp = F.state + base; float* op = F.out + O_RS + base;
    f32x4 o = (f32x4){0.f, 0.f, 0.f, 0.f};
#pragma unroll
    for (int i0 = 0; i0 < 4; ++i0) { f32x4 R[8];
#pragma unroll
        for (int j = 0; j < 8; ++j) { const int d = w + 8 * (i0 * 8 + j); R[j] = __builtin_nontemporal_load((const f32x4*)(sp + (size_t)d * 256)); }
#pragma unroll
        for (int j = 0; j < 8; ++j) { const int d = w + 8 * (i0 * 8 + j); const f32x4 rn = R[j] * gam + vv * ks[d]; __builtin_nontemporal_store(rn, (f32x4*)(op + (size_t)d * 256)); o += rn * qs[d]; } }
    *(LAS f32x4*)(red + w * 256 + lane * 4) = o;
    __syncthreads();
    if (w == 0) { f32x4 t = *(LAS f32x4*)(red + lane * 4);
#pragma unroll
        for (int k = 1; k < 8; ++k) t += *(LAS f32x4*)(red + k * 256 + lane * 4);
        const float mean = wave_sum(hsum4(t)) * (1.0f / 256.0f); const f32x4 d = t - mean; const float var = wave_sum(dot4(d, d)) * (1.0f / 256.0f); const float rs = 1.0f / sqrtf(var + EPS);
        const f32x4 gr = *(const f32x4*)(F.g_ret + h * 256 + lane * 4), rg = unpk4(*(const u32x2*)(zr + ZC_RG + h * 256 + lane * 4));
        *(u32x2*)(F.BACT + row * RW + h * 256 + lane * 4) = pack4(d * rs * gr * rg); }
}
__device__ __forceinline__ void xattn_sample_item(const Frame& F, int req, int mh) {
    LAS float* cq = (LAS float*)F.lds; LAS float* sc = cq + 256; LAS float* red = cq + 512; LAS float* misc = cq + 512 + 2048;
    const int w = F.wave, tid = launder(F.tid), lane = tid & 63; const size_t row = (size_t)MP + req; const bf16_t* zr = F.Z + row * LDZ;
    __syncthreads();
    if (tid < 256) cq[tid] = bf1(zr[ZC_CQ + mh * 256 + tid]);
    __syncthreads();
    { const int sub = lane >> 4, li = lane & 15; f32x4 cqr[4];
#pragma unroll
      for (int c = 0; c < 4; ++c) cqr[c] = *(LAS f32x4*)(cq + 4 * (li + 16 * c));
#pragma unroll
      for (int g0 = 0; g0 < 8; g0 += 4) { f32x4 kk[4][4];
#pragma unroll
          for (int g = 0; g < 4; ++g) { const int m = 32 * w + 4 * (g0 + g) + sub; const float* kp = F.cmk + (((size_t)req * 256 + m) * 4 + mh) * 256;
#pragma unroll
              for (int c = 0; c < 4; ++c) kk[g][c] = __builtin_nontemporal_load((const f32x4*)(kp + 4 * (li + 16 * c))); }
#pragma unroll
          for (int g = 0; g < 4; ++g) { float dsum = (dot4(kk[g][0], cqr[0]) + dot4(kk[g][1], cqr[1])) + (dot4(kk[g][2], cqr[2]) + dot4(kk[g][3], cqr[3]));
              dsum += __shfl_xor(dsum, 1); dsum += __shfl_xor(dsum, 2); dsum += __shfl_xor(dsum, 4); dsum += __shfl_xor(dsum, 8);
              if (li == 0) sc[32 * w + 4 * (g0 + g) + sub] = dsum; } } }
    __syncthreads();
    if (w == 0) { f32x4 s4 = *(LAS f32x4*)(sc + 4 * lane); const float mx = wave_max(fmaxf(fmaxf(s4[0], s4[1]), fmaxf(s4[2], s4[3])));
#pragma unroll
        for (int e = 0; e < 4; ++e) s4[e] = ex2((s4[e] - mx) * 1.4426950408889634f);
        const float sum = wave_sum(hsum4(s4)); *(LAS f32x4*)(sc + 4 * lane) = s4; if (lane == 0) misc[0] = 1.0f / sum; }
    __syncthreads();
    f32x4 o = (f32x4){0.f, 0.f, 0.f, 0.f};
#pragma unroll
    for (int i0 = 0; i0 < 4; ++i0) { f32x4 V[8];
#pragma unroll
        for (int j = 0; j < 8; ++j) { const int m = w + 8 * (i0 * 8 + j); V[j] = __builtin_nontemporal_load((const f32x4*)(F.cmv + (((size_t)req * 256 + m) * 4 + mh) * 256 + lane * 4)); }
#pragma unroll
        for (int j = 0; j < 8; ++j) { const int m = w + 8 * (i0 * 8 + j); o += V[j] * sc[m]; } }
    *(LAS f32x4*)(red + w * 256 + lane * 4) = o;
    __syncthreads();
    if (w == 0) { f32x4 t = *(LAS f32x4*)(red + lane * 4);
#pragma unroll
        for (int k = 1; k < 8; ++k) t += *(LAS f32x4*)(red + k * 256 + lane * 4);
        const f32x4 cg = unpk4(*(const u32x2*)(zr + ZC_CG + mh * 256 + lane * 4));
        *(u32x2*)(F.CACT + row * MW + mh * 256 + lane * 4) = pack4(t * misc[0] * cg); }
}

__device__ __forceinline__ void ret_out_unit(const Frame& F, int b, int h, int c) {
    LAS unsigned char* img = F.lds; const int w = F.wave, tid = launder(F.tid), lane = tid & 63, fr = lane & 15, fq = lane >> 4;
    LAS unsigned char* Pw = F.lds + 67584 + w * 4352;
    const size_t r0 = (size_t)b * 2048 + c * 128; const int i = 16 * w + fr; const float l2g = log2gamma(h);
    bf16x8 qf[8];
#pragma unroll
    for (int s = 0; s < 8; ++s) qf[s] = *(const bf16x8*)(F.Z + (r0 + i) * LDZ + ZC_Q + h * 256 + 32 * s + 8 * fq);
    f32x4 acc[16];
#pragma unroll
    for (int n = 0; n < 16; ++n) acc[n] = (f32x4){0.f, 0.f, 0.f, 0.f};
    __syncthreads();
    if (c > 0) {
        stage_tile256<256>(img, F.RS + ((size_t)(b * 8 + h) * 15 + (c - 1)) * 65536, 256, tid);
        __syncthreads();
#pragma unroll
        for (int n = 0; n < 16; ++n) {
#pragma unroll
            for (int s = 0; s < 8; ++s) acc[n] = mma(acc[n], *(const LAS bf16x8*)(img + (16 * n + fr) * IMG_PITCH + (32 * s + 8 * fq) * 2), qf[s]);
            __builtin_amdgcn_sched_barrier(0); }
        const float dq = ex2((float)(i + 1) * l2g);
#pragma unroll
        for (int n = 0; n < 16; ++n) acc[n] = acc[n] * dq;
        __syncthreads();
    }
    stage_tile256<128>(img, F.Z + r0 * LDZ + ZC_K + h * 256, LDZ, tid);
    __syncthreads();
#pragma unroll
    for (int n = 0; n < 8; ++n) {
        f32x4 sa = (f32x4){0.f, 0.f, 0.f, 0.f};
        if (n <= w) {
#pragma unroll
            for (int s = 0; s < 8; ++s) sa = mma(sa, *(const LAS bf16x8*)(img + (16 * n + fr) * IMG_PITCH + (32 * s + 8 * fq) * 2), qf[s]);
#pragma unroll
            for (int e = 0; e < 4; ++e) { const int dij = i - (16 * n + 4 * fq + e); sa[e] = dij >= 0 ? sa[e] * ex2((float)dij * l2g) : 0.f; }
        }
        *(LAS u32x2*)(Pw + fr * 272 + (16 * n + 4 * fq) * 2) = pack4(sa); __builtin_amdgcn_sched_barrier(0);
    }
    __syncthreads();
    stage_tile256<128>(img, F.Z + r0 * LDZ + ZC_RV + h * 256, LDZ, tid);
    __syncthreads();
    const int smax = w >> 1;
#pragma unroll
    for (int s = 0; s < 4; ++s) if (s <= smax) {
        const bf16x8 pf = *(const LAS bf16x8*)(Pw + fr * 272 + (32 * s + 8 * fq) * 2);
#pragma unroll
        for (int n = 0; n < 16; ++n) { acc[n] = mma(acc[n], tr_frag(img, IMG_PITCH, 32 * s, 16 * n, lane), pf); if ((n & 3) == 3) __builtin_amdgcn_sched_barrier(0); }
    }
    float sm = 0.f;
#pragma unroll
    for (int n = 0; n < 16; ++n) sm += hsum4(acc[n]);
    sm += __shfl_xor(sm, 16); sm += __shfl_xor(sm, 32); const float mean = sm * (1.0f / 256.0f);
    float sq = 0.f;
#pragma unroll
    for (int n = 0; n < 16; ++n) { acc[n] = acc[n] - mean; sq += dot4(acc[n], acc[n]); }
    sq += __shfl_xor(sq, 16); sq += __shfl_xor(sq, 32); const float rs = 1.0f / sqrtf(sq * (1.0f / 256.0f) + EPS);
    const bf16_t* zr = F.Z + (r0 + i) * LDZ + ZC_RG + h * 256; bf16_t* br = F.BACT + (r0 + i) * RW + h * 256;
#pragma unroll
    for (int n = 0; n < 16; ++n) { const int dv = 16 * n + 4 * fq; const f32x4 gr = *(const f32x4*)(F.g_ret + h * 256 + dv), rg = unpk4(*(const u32x2*)(zr + dv));
        *(u32x2*)(br + dv) = pack4(acc[n] * rs * gr * rg); }
}
__device__ __forceinline__ void xattn_unit(const Frame& F, int b, int mh, int qb) {
    LAS unsigned char* img = F.lds; const int w = F.wave, tid = launder(F.tid), lane = tid & 63, fr = lane & 15, fq = lane >> 4;
    LAS unsigned char* Pw = F.lds + w * 8448; LAS unsigned char* imgV = F.lds + 67584;
    const size_t r0 = (size_t)b * 2048 + qb * 128; const int i = 16 * w + fr;
    bf16x8 qf[8];
#pragma unroll
    for (int s = 0; s < 8; ++s) qf[s] = *(const bf16x8*)(F.Z + (r0 + i) * LDZ + ZC_CQ + mh * 256 + 32 * s + 8 * fq);
    __syncthreads();
    stage_tile256<256>(img, F.MKV + (size_t)(b * 256) * 2048 + mh * 256, 2048, tid);
    __syncthreads();
    f32x4 acc[16];
#pragma unroll
    for (int n = 0; n < 16; ++n) { acc[n] = (f32x4){0.f, 0.f, 0.f, 0.f};
#pragma unroll
        for (int s = 0; s < 8; ++s) acc[n] = mma(acc[n], *(const LAS bf16x8*)(img + (16 * n + fr) * IMG_PITCH + (32 * s + 8 * fq) * 2), qf[s]); __builtin_amdgcn_sched_barrier(0); }
    float mx = -3.0e38f;
#pragma unroll
    for (int n = 0; n < 16; ++n) mx = fmaxf(mx, fmaxf(fmaxf(acc[n][0], acc[n][1]), fmaxf(acc[n][2], acc[n][3])));
    mx = fmaxf(mx, __shfl_xor(mx, 16)); mx = fmaxf(mx, __shfl_xor(mx, 32));
    float sm = 0.f;
#pragma unroll
    for (int n = 0; n < 16; ++n) {
#pragma unroll
        for (int e = 0; e < 4; ++e) acc[n][e] = ex2((acc[n][e] - mx) * 1.4426950408889634f);
        sm += hsum4(acc[n]); }
    sm += __shfl_xor(sm, 16); sm += __shfl_xor(sm, 32); const float inv = 1.0f / sm;
    __syncthreads();
#pragma unroll
    for (int n = 0; n < 16; ++n) { *(LAS u32x2*)(Pw + fr * IMG_PITCH + (16 * n + 4 * fq) * 2) = pack4(acc[n]); acc[n] = (f32x4){0.f, 0.f, 0.f, 0.f}; }
#pragma unroll
    for (int hf = 0; hf < 2; ++hf) {
        stage_tile256<128>(imgV, F.MKV + (size_t)(b * 256 + hf * 128) * 2048 + 1024 + mh * 256, 2048, tid);
        __syncthreads();
#pragma unroll
        for (int s = 0; s < 4; ++s) { const bf16x8 pf = *(const LAS bf16x8*)(Pw + fr * IMG_PITCH + (hf * 128 + 32 * s + 8 * fq) * 2);
#pragma unroll
            for (int n = 0; n < 16; ++n) { acc[n] = mma(acc[n], tr_frag(imgV, IMG_PITCH, 32 * s, 16 * n, lane), pf); if ((n & 3) == 3) __builtin_amdgcn_sched_barrier(0); } }
        __syncthreads();
    }
    const bf16_t* zr = F.Z + (r0 + i) * LDZ + ZC_CG + mh * 256; bf16_t* cr = F.CACT + (r0 + i) * MW + mh * 256;
#pragma unroll
    for (int n = 0; n < 16; ++n) { const int dv = 16 * n + 4 * fq; *(u32x2*)(cr + dv) = pack4(acc[n] * inv * unpk4(*(const u32x2*)(zr + dv))); }
}

template <int K>
__device__ __forceinline__ f32x4 skinny_dot(const bf16_t* arow, const bf16_t* brow) {
    f32x4 a0 = (f32x4){0.f, 0.f, 0.f, 0.f}, a1 = a0, a2 = a0, a3 = a0;
#pragma unroll 2
    for (int s = 0; s < K / 32; s += 8) {
        bf16x8 fa[8], fb[8];
#pragma unroll
        for (int j = 0; j < 8; ++j) { fa[j] = *(const bf16x8*)(arow + 32 * (s + j)); fb[j] = *(const bf16x8*)(brow + 32 * (s + j)); }
        a0 = mma(a0, fb[0], fa[0]); a1 = mma(a1, fb[1], fa[1]); a2 = mma(a2, fb[2], fa[2]); a3 = mma(a3, fb[3], fa[3]);
        a0 = mma(a0, fb[4], fa[4]); a1 = mma(a1, fb[5], fa[5]); a2 = mma(a2, fb[6], fa[6]); a3 = mma(a3, fb[7], fa[7]);
    }
    return (a0 + a1) + (a2 + a3);
}

struct Args { const float* in[19]; float* out; unsigned char* ws; int ph_lo, ph_hi; };
__global__ void __launch_bounds__(512, 2) mega_fwd(Args args) {
    extern __shared__ __attribute__((aligned(16))) unsigned char lds[];
    Frame F;
    F.lds = (LAS unsigned char*)lds;
    volatile LAS unsigned* MISC = (volatile LAS unsigned*)(F.lds + MISC_OFF);
    F.tid = threadIdx.x; F.lane = F.tid & 63; F.wave = __builtin_amdgcn_readfirstlane(F.tid >> 6); F.G = gridDim.x; F.cu = blockIdx.x;
    F.xp = args.in[0]; F.xs = args.in[1]; F.state = args.in[2]; F.cmk = args.in[3]; F.cmv = args.in[4]; F.memp = args.in[5]; F.g_pre = args.in[6]; F.w_in = args.in[7]; F.g_anorm = args.in[8];
    F.w_s = args.in[9]; F.b_s = args.in[10]; F.g_ret = args.in[11]; F.g_mem = args.in[12]; F.w_mem = args.in[13]; F.w_oa = args.in[14]; F.w_ob = args.in[15]; F.w_oc = args.in[16]; F.w_out = args.in[17]; F.g_final = args.in[18];
    F.out = args.out; F.ws = args.ws; unsigned char* ws = args.ws;
    F.WinT = (bf16_t*)(ws + WS_WIN); F.WmemT = (bf16_t*)(ws + WS_WMEM); F.WoaT = (bf16_t*)(ws + WS_WOA); F.WobT = (bf16_t*)(ws + WS_WOB); F.WocT = (bf16_t*)(ws + WS_WOC); F.WoutT = (bf16_t*)(ws + WS_WOUT);
    F.H = (bf16_t*)(ws + WS_H); F.MEMN = (bf16_t*)(ws + WS_MEMN); F.Z = (bf16_t*)(ws + WS_Z); F.MKV = (bf16_t*)(ws + WS_MKV); F.RS = (bf16_t*)(ws + WS_RS);
    F.AACT = (bf16_t*)(ws + WS_AACT); F.BACT = (bf16_t*)(ws + WS_BACT); F.CACT = (bf16_t*)(ws + WS_CACT); F.MG = (bf16_t*)(ws + WS_MG);
    F.ropec = (float*)(ws + WS_ROPE); F.ropes = F.ropec + 2049 * 128; F.statv = (float*)(ws + WS_STATV); F.stato = (float*)(ws + WS_STATO); F.stats = (float*)(ws + WS_STATS);
    for (int u = F.tid; u < (LDS_BYTES - MISC_OFF) / 4; u += 512) ((LAS unsigned*)(F.lds + MISC_OFF))[u] = 0u;
    __syncthreads();
    XcdBarrier bar; bar.bar = (unsigned*)(ws + WS_CTL) + CW_BAR; bar.x = 0; bar.st = nullptr;
    if (MK_N_LAUNCHES == 1) bar = xcd_barrier_post((unsigned*)(ws + WS_CTL) + CW_BAR, MISC + 8);
    const int lo = args.ph_lo, hi = args.ph_hi;
#ifndef PHASE_MASK
#define PHASE_MASK 0x7f
#endif
#define IN(k) (((PHASE_MASK >> (k)) & 1) && lo <= (k) && (k) < hi)
#define SEAM(k) do { if (IN(k) && IN((k) + 1)) xcd_barrier(bar); } while (0)
#ifndef REPEAT_PHASE
#define REPEAT_PHASE (-1)
#endif
#define REP(k) for (int rp_ = 0; rp_ < ((REPEAT_PHASE == (k)) ? 2 : 1); ++rp_, (void)((REPEAT_PHASE == (k) && rp_ == 1) ? (xcd_barrier(bar), 0) : 0))

    if (IN(0)) REP(0) { p0_prologue(F); }
    SEAM(0);
    if (IN(1)) REP(1) {
        pg8::Order S; S.init(F.H, F.WinT, MPAD, NIN, F.G, F.cu); S.A1 = F.MEMN; S.B1 = F.WmemT; S.nX = 32; S.nXn = 8;
        EpiZ E{F.Z, F.statv, F.ropec, F.ropes, F.out + O_MK, F.out + O_MV, F.MKV};
        pg8::gemm_phase<EpiZ, pg8::Order, true>(F.lds, D, S, E);
    }
    SEAM(1);
    if (IN(2)) REP(2) {
        for (int u = F.cu; u < 256; u += F.G) scan_unit(F, u >> 6, (u >> 3) & 7, u & 7);
        for (int u = F.cu; u < 512; u += F.G) spatial_unit(F, u >> 7, (u >> 3) & 15, (u >> 1) & 3, u & 1);
        for (int s = F.cu * 8 + F.wave; s < MS; s += F.G * 8) spatial_sample_row(F, s);
        for (int u = F.cu; u < 1024; u += F.G) ret_sample_item(F, u >> 3, u & 7);
        for (int u = F.cu; u < 512; u += F.G) xattn_sample_item(F, u >> 2, u & 3);
#ifdef DIAG_ZERO_Y
        for (size_t i = (size_t)F.cu * 512 + F.tid; i < (O_RP / 4); i += (size_t)F.G * 512) ((f32x4*)F.out)[i] = (f32x4){0.f, 0.f, 0.f, 0.f};
#endif
    }
    SEAM(2);
    if (IN(3)) REP(3) {
        for (int u = F.cu; u < 512; u += F.G) ret_out_unit(F, u >> 7, (u >> 4) & 7, u & 15);
        for (int u = F.cu; u < 256; u += F.G) xattn_unit(F, u >> 6, (u >> 4) & 3, u & 15);
        __syncthreads();
    }
    SEAM(3);
    if (IN(4)) REP(4) {
        for (int pass = 0; pass < 3; ++pass) {
            const bf16_t* A = pass == 0 ? F.AACT : (pass == 1 ? F.BACT : F.CACT); const bf16_t* Bt = pass == 0 ? F.WoaT : (pass == 1 ? F.WobT : F.WocT); const int K = pass == 2 ? MW : AW;
            pg8::Order S; S.init(A, Bt, MP, D, F.G, F.cu);
            EpiMerge E{F.Z, F.MG, pass};
            pg8::gemm_phase<EpiMerge, pg8::Order>(F.lds, K, S, E);
        }
        { const int w = F.wave, fr = F.lane & 15, fq = F.lane >> 4; const size_t row = (size_t)MP + 16 * w + fr;
          for (int nt = F.cu; nt < 256; nt += F.G) { const int n0 = 16 * nt;
              const f32x4 ya = skinny_dot<AW>(F.AACT + row * AW + 8 * fq, F.WoaT + (size_t)(n0 + fr) * AW + 8 * fq);
              const f32x4 yb = skinny_dot<RW>(F.BACT + row * RW + 8 * fq, F.WobT + (size_t)(n0 + fr) * RW + 8 * fq);
              const f32x4 yc = skinny_dot<MW>(F.CACT + row * MW + 8 * fq, F.WocT + (size_t)(n0 + fr) * MW + 8 * fq);
              const bf16_t* gz = F.Z + row * LDZ + ZC_GS + n0 + 4 * fq;
              const f32x4 g0 = unpk4(*(const u32x2*)gz), g1 = unpk4(*(const u32x2*)(gz + D)), g2 = unpk4(*(const u32x2*)(gz + 2 * D));
              *(u32x2*)(F.MG + row * D + n0 + 4 * fq) = pack4(g0 * ya + g1 * yb + g2 * yc); } }
    }
    SEAM(4);
    if (IN(5)) REP(5) {
        { pg8::Order S; S.init(F.MG, F.WoutT, MP, D, F.G, F.cu);
          EpiOut E{F.xp, F.out + O_YP, F.stato};
          pg8::gemm_phase<EpiOut, pg8::Order>(F.lds, D, S, E); }
        { const int w = F.wave, fr = F.lane & 15, fq = F.lane >> 4; const int r = 16 * w + fr; const size_t row = (size_t)MP + r;
          for (int nt = F.cu; nt < 256; nt += F.G) { const int n0 = 16 * nt;
              const f32x4 y = skinny_dot<D>(F.MG + row * D + 8 * fq, F.WoutT + (size_t)(n0 + fr) * D + 8 * fq);
              const f32x4 v = *(const f32x4*)(F.xs + (size_t)r * D + n0 + 4 * fq) + y;
              *(f32x4*)(F.out + O_YS + (size_t)r * D + n0 + 4 * fq) = v;
              float q = dot4(v, v); q += __shfl_xor(q, 16); q += __shfl_xor(q, 32);
              if (fq == 0) F.stats[r * 256 + nt] = q; } }
    }
    SEAM(5);
    if (IN(6)) {
        const int lane = F.lane;
        for (int m = F.cu * 8 + F.wave; m < MREAL; m += F.G * 8) {
            float q; float* yr;
            if (m < MP) { q = wave_sum(F.stato[(size_t)m * 64 + lane]); yr = F.out + O_YP + (size_t)m * D; }
            else { const float* sp = F.stats + (size_t)(m - MP) * 256; q = wave_sum((sp[lane] + sp[lane + 64]) + (sp[lane + 128] + sp[lane + 192])); yr = F.out + O_YS + (size_t)(m - MP) * D; }
            const float r = 1.0f / sqrtf(q * (1.0f / 4096.0f) + EPS);
            f32x4* y4 = (f32x4*)yr + lane; const f32x4* g4 = (const f32x4*)F.g_final + lane;
            f32x4 v[16];
#pragma unroll
            for (int j = 0; j < 16; ++j) v[j] = y4[64 * j];
#pragma unroll
            for (int j = 0; j < 16; ++j) y4[64 * j] = v[j] * r * g4[64 * j];
        }
    }
#undef IN
#undef SEAM
}


__global__ void diag_hash(const unsigned char* ws, unsigned long long* table) {
    const unsigned* Z = (const unsigned*)(ws + WS_Z);
    const int segs[6] = {12288, 14336, 15360, 16384, 20480, 24576}; const int wid[6] = {2048, 1024, 1024, 4096, 4096, 4096};
    for (int r = 0; r < 6; ++r) { const int c0 = segs[r] / 2, nc = wid[r] / 2; unsigned long long h = 0;
        for (size_t i = (size_t)blockIdx.x * blockDim.x + threadIdx.x; i < (size_t)MPAD * nc; i += (size_t)gridDim.x * blockDim.x) { const size_t row = i / nc, c = i % nc; h += (unsigned long long)Z[row * (LDZ / 2) + c0 + c] * (unsigned long long)(i * 2654435761ull + 12345ull); }
        for (int o = 32; o >= 1; o >>= 1) h += __shfl_xor(h, o);
        if ((threadIdx.x & 63) == 0) atomicAdd(table + r, h); }
}
__global__ void diag_finish(float* out, const unsigned long long* t0, const unsigned long long* t1) {
    int mask = 0; for (int r = 0; r < 6; ++r) if (t0[r] != t1[r]) mask |= 1 << r;
    for (size_t i = (size_t)blockIdx.x * blockDim.x + threadIdx.x; i < O_END; i += (size_t)gridDim.x * blockDim.x) out[i] = (i == 0) ? __uint_as_float((unsigned)(127 + 10 + mask) << 23) : 0.f;
}
extern "C" void kernel_launch(void* const* d_in, const int* in_sizes, int n_in, void* d_out, int out_size, void* d_ws, size_t ws_size, hipStream_t stream) {
    static int grid = 0;
    if (grid == 0) {
        if (n_in != 19 || out_size != (int)O_END || ws_size < WS_END) { fprintf(stderr, "kernel_launch: unexpected problem shape (n_in %d, out %d, ws %zu); nothing launched\n", n_in, out_size, ws_size); grid = -1; return; }
        int dev = 0, cus = 0, per_cu = 0;
        if (hipGetDevice(&dev) != hipSuccess || hipDeviceGetAttribute(&cus, hipDeviceAttributeMultiprocessorCount, dev) != hipSuccess) { grid = -1; return; }
        if (hipFuncSetAttribute((const void*)mega_fwd, hipFuncAttributeMaxDynamicSharedMemorySize, LDS_BYTES) != hipSuccess) { fprintf(stderr, "kernel_launch: hipFuncSetAttribute failed\n"); grid = -1; return; }
        if (hipOccupancyMaxActiveBlocksPerMultiprocessor(&per_cu, (const void*)mega_fwd, 512, LDS_BYTES) != hipSuccess || per_cu < 1) fprintf(stderr, "kernel_launch: occupancy query says %d blocks per CU\n", per_cu);
        (void)hipGetLastError();
        grid = cus;
    }
    if (grid < 0) return;
    (void)hipMemsetAsync((char*)d_ws + WS_CTL, 0, CTL_ZERO_BYTES, stream);
    Args a{};
    for (int i = 0; i < 19; ++i) a.in[i] = (const float*)d_in[i];
    a.out = (float*)d_out; a.ws = (unsigned char*)d_ws;
#ifdef DIAG_DET
    for (int rep = 0; rep < 2; ++rep) { a.ph_lo = 0; a.ph_hi = 2; if (rep) (void)hipMemsetAsync((char*)d_ws + WS_CTL, 0, 32 * 1024, stream);
        hipLaunchKernelGGL(mega_fwd, dim3(grid), dim3(512), LDS_BYTES, stream, a);
        hipLaunchKernelGGL(diag_hash, dim3(1024), dim3(256), 0, stream, (const unsigned char*)d_ws, (unsigned long long*)((char*)d_ws + 32 * 1024 + rep * 1024)); }
    hipLaunchKernelGGL(diag_finish, dim3(1024), dim3(256), 0, stream, (float*)d_out, (const unsigned long long*)((char*)d_ws + 32 * 1024), (const unsigned long long*)((char*)d_ws + 33 * 1024));
    return;
#endif
    if (MK_N_LAUNCHES == 1) { a.ph_lo = 0; a.ph_hi = 7; hipLaunchKernelGGL(mega_fwd, dim3(grid), dim3(512), LDS_BYTES, stream, a); }
    else { for (int p = 0; p < 7; ++p) { a.ph_lo = p; a.ph_hi = p + 1; hipLaunchKernelGGL(mega_fwd, dim3(grid), dim3(512), LDS_BYTES, stream, a); } }
}
```

```cpp
#include <hip/hip_runtime.h>
#include <cstdio>
#include <cstdint>

#ifndef MK_N_LAUNCHES
#define MK_N_LAUNCHES 1
#endif

#define LAS __attribute__((address_space(3)))
#define GAS __attribute__((address_space(1)))
typedef unsigned short bf16_t;
typedef short bf16x8 __attribute__((ext_vector_type(8)));
typedef short s16x4 __attribute__((ext_vector_type(4)));
typedef float f32x4 __attribute__((ext_vector_type(4)));
typedef float f32x2 __attribute__((ext_vector_type(2)));
typedef unsigned u32x4 __attribute__((ext_vector_type(4)));
typedef unsigned u32x2 __attribute__((ext_vector_type(2)));
typedef int i32x4 __attribute__((ext_vector_type(4)));
typedef GAS unsigned gu32;

constexpr int D = 4096, MP = 8192, MS = 128, MREAL = MP + MS, MPAD = 8448;
constexpr int NIN = 28672, LDZ = NIN, AW = 2048, RW = 2048, MW = 1024;
constexpr int ZC_U = 0, ZC_V = 2048, ZC_G = 4096, ZC_Q = 6144, ZC_K = 8192, ZC_RV = 10240, ZC_RG = 12288, ZC_CQ = 14336, ZC_CG = 15360, ZC_GS = 16384;
constexpr float EPS = 1e-6f;
constexpr size_t O_YP = 0, O_YS = 33554432, O_RP = 34078720, O_MK = 36175872, O_MV = 37224448, O_RS = 38273024, O_GV = 105381888, O_END = 105644032;

constexpr size_t MiB = 1u << 20;
constexpr size_t WS_CTL = 0, CTL_ZERO_BYTES = 256 * 1024;
constexpr size_t WS_CMAX = 128 * 1024;
constexpr size_t WS_ROPE = 1 * MiB;
constexpr size_t WS_STATV = 4 * MiB;
constexpr size_t WS_STATO = 7 * MiB;
constexpr size_t WS_STATS = 10 * MiB;
constexpr size_t WS_WIN = 16 * MiB;
constexpr size_t WS_WMEM = 240 * MiB;
constexpr size_t WS_WOA = 256 * MiB;
constexpr size_t WS_WOB = 272 * MiB;
constexpr size_t WS_WOC = 288 * MiB;
constexpr size_t WS_WOUT = 296 * MiB;
constexpr size_t WS_H = 328 * MiB;
constexpr size_t WS_MEMN = 394 * MiB;
constexpr size_t WS_Z = 402 * MiB;
constexpr size_t WS_MKV = 864 * MiB;
constexpr size_t WS_RS = 868 * MiB;
constexpr size_t WS_AACT = 928 * MiB;
constexpr size_t WS_BACT = 961 * MiB;
constexpr size_t WS_CACT = 994 * MiB;
constexpr size_t WS_MG = 1012 * MiB;
constexpr size_t WS_H8 = 1100 * MiB;
constexpr size_t WS_W8 = 1136 * MiB;
constexpr size_t WS_SH = 12 * MiB;
constexpr size_t WS_SW = 13 * MiB;
constexpr size_t WS_END = 1232 * MiB;
static_assert(WS_WIN + (size_t)NIN * D * 2 <= WS_WMEM && WS_H + (size_t)MPAD * D * 2 <= WS_MEMN && WS_Z + (size_t)MPAD * LDZ * 2 <= WS_MKV, "ws map");
static_assert(WS_RS + (size_t)480 * 65536 * 2 <= WS_AACT && WS_AACT + (size_t)MPAD * AW * 2 <= WS_BACT && WS_CACT + (size_t)MPAD * MW * 2 <= WS_MG && WS_MG + (size_t)MPAD * D * 2 <= WS_END, "ws map 2");
constexpr int CW_BAR = 1024;

constexpr int RING_BYTES = 131072;
constexpr int IMG_PITCH = 528;
constexpr int SMALL_OFF = 135168;
constexpr int MISC_OFF = 151552;
constexpr int LDS_BYTES = 155648;

#define LDS_WAIT() asm volatile("s_waitcnt lgkmcnt(0)" ::: "memory")
#define VM_WAIT() asm volatile("s_waitcnt vmcnt(0)" ::: "memory")

namespace pg8 {
constexpr int BM = 256, BK = 64, HALF = 128, HTB = HALF * BK * 2, STAGE_BYTES = 8 * HTB, NXCD = 8, WGM = 8;
__host__ __device__ __forceinline__ int lds_byte(int r, int c) { const int st = (r >> 4) * 2 + (c >> 5), rr = r & 15, cc = c & 31, ob = rr * 64 + cc * 2; return st * 1024 + (ob ^ (((ob >> 9) & 1) << 5)); }
__host__ __device__ __forceinline__ void stage_rc(int b, int& R, int& C) { const int st = b / 1024, sb = b % 1024, swz = sb ^ (((sb >> 9) & 1) << 5); R = (st >> 1) * 16 + swz / 64; C = (st & 1) * 32 + (swz % 64) / 2; }
__host__ __device__ __forceinline__ int perm32(int rho) { const int n = rho >> 4, i = rho & 15; return 8 * (i >> 2) + 4 * n + (i & 3); }

struct Unit { int pm, pn, kind; };

struct Order {
    const bf16_t *A0, *B0, *A1, *B1; int nM, nN, nwg, nX, nXn, G, c;
    __device__ __forceinline__ void init(const bf16_t* a0, const bf16_t* b0, int M, int N, int G_, int c_) { A0 = a0; B0 = b0; A1 = a0; B1 = b0; nM = M / BM; nN = N / BM; nwg = nM * nN; nX = 0; nXn = 1; G = G_; c = c_; }
    __device__ __forceinline__ bool next(int i, Unit& u) const {
        const long L = (long)i * G + c; const bool ok = L < nwg + nX; const bool ex = L >= nwg;
        const int r = (int)L - nwg;
        int wgid = ex ? 0 : (int)L; { const int q = nwg / NXCD, rr = nwg % NXCD, xcd = wgid % NXCD, off = wgid / NXCD; wgid = (xcd < rr ? xcd * (q + 1) : rr * (q + 1) + (xcd - rr) * q) + off; }
        const int nig = WGM * nN, gid = wgid / nig, fm = gid * WGM, gsz = (nM - fm) < WGM ? (nM - fm) : WGM;
        const int pm0 = fm + ((wgid % nig) % gsz), pn0 = (wgid % nig) / gsz;
        const int pm = ex ? r / nXn : pm0, pn = ex ? r % nXn : pn0;
        u.pm = pm; u.pn = pn; u.kind = ex ? 1 : 0; return ok;
    }
    __device__ __forceinline__ void operands(const Unit& u, size_t tstep, const char*& a, const char*& b) const {
        a = (const char*)(u.kind ? A1 : A0) + (size_t)u.pm * tstep; b = (const char*)(u.kind ? B1 : B0) + (size_t)u.pn * tstep; }
};

struct OrderP1 {
    const void* A; const void* B; int G, c, i8;
    __device__ __forceinline__ bool next(int i, Unit& u) const {
        if (!i8) { const long L = (long)i * G + c; const bool ok = L < 536; const bool smp = L >= 512; const int t = (int)L - 512;
            int wgid = smp ? 0 : (int)L; wgid = (wgid % 8) * 64 + wgid / 8;
            const int pm0 = (wgid / 128) * 8 + ((wgid % 128) % 8), pn0 = 32 + (wgid % 128) / 8;
            u.pm = smp ? 32 : pm0; u.pn = smp ? (t < 8 ? 8 + t : 24 + t) : pn0; u.kind = 0; return ok; }
        long j = (long)i * G + c;
        if (G == 256) { j = 1 << 30; if (i < 11) j = c + 256 * i; else if (i == 11 && c >= 24) j = 2816 + (c - 24); else if (i == 12 && c >= 24 && c < 144) j = 3048 + (c - 24); }
        const bool ok = j < 3168;
        int wgid = ok ? (int)j : 0; wgid = (wgid % 8) * 396 + wgid / 8;
        const int gid = wgid / 768, fm = gid * 8, gsz = (33 - fm) < 8 ? (33 - fm) : 8;
        u.pm = fm + ((wgid % 768) % gsz); u.pn = (wgid % 768) / gsz; u.kind = 0; return ok;
    }
    __device__ __forceinline__ void operands(const Unit& u, size_t tstep, const char*& a, const char*& b) const { a = (const char*)A + (size_t)u.pm * tstep; b = (const char*)B + (size_t)u.pn * tstep; }
};

typedef float cvf32x2_t __attribute__((ext_vector_type(2))); typedef __bf16 cvbf16x2_t __attribute__((ext_vector_type(2)));
__device__ __forceinline__ unsigned cvt_pk_bf16(float lo, float hi) { cvf32x2_t v = {lo, hi}; cvbf16x2_t b = __builtin_convertvector(v, cvbf16x2_t); return __builtin_bit_cast(unsigned, b); }

template <class Epi, class Sched, bool IMG = false, bool I8 = false, bool ALIGN_EPI = true, bool SP2 = true>
__device__ __forceinline__ void gemm_phase(LAS unsigned char* lds, const int K, const Sched& S, const Epi& E) {
    const int tid = threadIdx.x, wid = __builtin_amdgcn_readfirstlane(tid >> 6), lane = tid & 63, wr = wid >> 2, wc = wid & 3, fr = lane & 15, fq = lane >> 4;
    const int nt = I8 ? K / 128 : K / BK;
    unsigned voffA[2], voffB[2];
#pragma unroll
    for (int i = 0; i < 2; ++i) { int R, C; stage_rc(tid * 16 + i * 8192, R, C); const int Rb = Epi::PERM ? ((R & ~31) + perm32(R & 31)) : R;
        voffA[i] = (unsigned)(R * K + C) * 2u; voffB[i] = (unsigned)(Rb * K + C) * 2u;
        if (IMG) { voffA[i] = (unsigned)(tid * 16 + i * 8192); voffB[i] = voffA[i]; } }
    const size_t kstep = IMG ? (size_t)HTB : (size_t)(BK * 2);
    const size_t hstep = (size_t)HALF * K * (I8 ? 1 : 2);
    const size_t tstep = 2 * hstep;
    const unsigned ldsw = (unsigned)wid * 1024u;
    const int aoff = lds_byte(wr * 64 + fr, fq * 8), boff = lds_byte(wc * 32 + fr, fq * 8);
#define PG8_SA(b, h) (((b) * 2 + (h)) * HTB)
#define PG8_SB(b, h) ((4 + (b) * 2 + (h)) * HTB)
#define PG8_STAGE(bufoff, gbase, voff) do { _Pragma("unroll") for (int _i = 0; _i < 2; ++_i) \
        __builtin_amdgcn_global_load_lds((const unsigned*)((const char*)(gbase) + (voff)[_i]), (LAS unsigned*)(lds + (bufoff) + ldsw + _i * 8192), 16, 0, 0); } while (0)
#define PG8_LDA(dst, b, h) do { _Pragma("unroll") for (int m = 0; m < 4; ++m) _Pragma("unroll") for (int k = 0; k < 2; ++k) dst[m][k] = *(const LAS bf16x8*)(lds + PG8_SA(b, h) + aoff + m * 2048 + k * 1024); } while (0)
#define PG8_LDB(dst, b, h) do { _Pragma("unroll") for (int n = 0; n < 2; ++n) _Pragma("unroll") for (int k = 0; k < 2; ++k) dst[n][k] = *(const LAS bf16x8*)(lds + PG8_SB(b, h) + boff + n * 2048 + k * 1024); } while (0)
#define PG8_MMA(ai, bj, At, Bt) do { __builtin_amdgcn_s_setprio(1); _Pragma("unroll") for (int m = 0; m < 4; ++m) _Pragma("unroll") for (int n = 0; n < 2; ++n) _Pragma("unroll") for (int k = 0; k < 2; ++k) \
        { if constexpr (I8) acc[ai][bj][m][n] = __builtin_bit_cast(f32x4, __builtin_amdgcn_mfma_i32_16x16x64_i8(__builtin_bit_cast(i32x4, Bt[n][k]), __builtin_bit_cast(i32x4, At[m][k]), __builtin_bit_cast(i32x4, acc[ai][bj][m][n]), 0, 0, 0)); \
          else acc[ai][bj][m][n] = __builtin_amdgcn_mfma_f32_16x16x32_bf16(Bt[n][k], At[m][k], acc[ai][bj][m][n], 0, 0, 0); } __builtin_amdgcn_s_setprio(0); } while (0)
#define PG8_WAIT_V(n) asm volatile("s_waitcnt vmcnt(" #n ")" ::: "memory")
#define PG8_WAIT_L(n) asm volatile("s_waitcnt lgkmcnt(" #n ")" ::: "memory")
#define PG8_BAR __builtin_amdgcn_s_barrier()
#define PG8_SCHED __builtin_amdgcn_sched_barrier(0)
    Unit cur, nxt; int ui = 0;
    if (!S.next(0, cur)) return;
    f32x4 acc[2][2][4][2];
#pragma unroll
    for (int a = 0; a < 2; ++a)
#pragma unroll
        for (int b = 0; b < 2; ++b)
#pragma unroll
            for (int m = 0; m < 4; ++m)
#pragma unroll
                for (int n = 0; n < 2; ++n) acc[a][b][m][n] = (f32x4){0.f, 0.f, 0.f, 0.f};
    bf16x8 At[4][2], B0[2][2], B1[2][2];
    const char* cA; const char* cB; S.operands(cur, tstep, cA, cB);
    if constexpr (SP2) {
        PG8_STAGE(PG8_SB(0, 0), cB, voffB); PG8_STAGE(PG8_SB(0, 1), cB + hstep, voffB); PG8_STAGE(PG8_SA(0, 0), cA, voffA); PG8_STAGE(PG8_SA(0, 1), cA + hstep, voffA);
        if (wr == 1) PG8_BAR;
        PG8_WAIT_V(2); PG8_BAR;
        PG8_STAGE(PG8_SB(1, 0), cB + kstep, voffB); PG8_STAGE(PG8_SA(1, 0), cA + kstep, voffA); PG8_STAGE(PG8_SB(1, 1), cB + hstep + kstep, voffB);
        PG8_WAIT_V(6); PG8_BAR;
    } else {
        PG8_STAGE(PG8_SB(0, 0), cB, voffB); PG8_STAGE(PG8_SA(0, 0), cA, voffA); PG8_STAGE(PG8_SB(0, 1), cB + hstep, voffB); PG8_STAGE(PG8_SA(0, 1), cA + hstep, voffA);
        if (wr == 1) PG8_BAR;
        PG8_WAIT_V(4); PG8_BAR;
        PG8_STAGE(PG8_SB(1, 0), cB + kstep, voffB); PG8_STAGE(PG8_SA(1, 0), cA + kstep, voffA); PG8_STAGE(PG8_SB(1, 1), cB + hstep + kstep, voffB);
        PG8_WAIT_V(6); PG8_BAR;
    }
    for (;;) {
        const bool has_next = S.next(ui + 1, nxt);
        const char* nA = cA; const char* nB = cB; if (has_next) S.operands(nxt, tstep, nA, nB);
        for (int t = 0; t < nt; t += 2) {
            const bool last = (t == nt - 2);
            const char* a1 = cA + (size_t)(t + 1) * kstep;
            const char* a2 = last ? nA : cA + (size_t)(t + 2) * kstep; const char* b2 = last ? nB : cB + (size_t)(t + 2) * kstep;
            const char* a3 = a2 + kstep; const char* b3 = b2 + kstep;
            if constexpr (SP2) {
            PG8_LDB(B0, 0, 0); PG8_LDB(B1, 0, 1); PG8_SCHED; PG8_LDA(At, 0, 0); PG8_STAGE(PG8_SA(1, 1), a1 + hstep, voffA);
            PG8_WAIT_V(8); PG8_WAIT_L(0); PG8_BAR; PG8_MMA(0, 0, At, B0); PG8_MMA(0, 1, At, B1); PG8_BAR; PG8_SCHED;
            PG8_LDA(At, 0, 1); PG8_STAGE(PG8_SB(0, 0), b2, voffB); PG8_STAGE(PG8_SB(0, 1), b2 + hstep, voffB); PG8_STAGE(PG8_SA(0, 0), a2, voffA);
            PG8_WAIT_V(8); PG8_WAIT_L(0); PG8_BAR; PG8_MMA(1, 0, At, B0); PG8_MMA(1, 1, At, B1); PG8_BAR; PG8_SCHED;
            PG8_LDB(B0, 1, 0); PG8_LDB(B1, 1, 1); PG8_SCHED; PG8_LDA(At, 1, 0); PG8_STAGE(PG8_SA(0, 1), a2 + hstep, voffA);
            PG8_WAIT_V(8); PG8_WAIT_L(0); PG8_BAR; PG8_MMA(0, 0, At, B0); PG8_MMA(0, 1, At, B1); PG8_BAR; PG8_SCHED;
            PG8_LDA(At, 1, 1); PG8_STAGE(PG8_SB(1, 0), b3, voffB); PG8_STAGE(PG8_SB(1, 1), b3 + hstep, voffB); PG8_STAGE(PG8_SA(1, 0), a3, voffA);
            PG8_WAIT_V(8); PG8_WAIT_L(0); PG8_BAR; PG8_MMA(1, 0, At, B0); PG8_MMA(1, 1, At, B1); PG8_BAR; PG8_SCHED;
            } else {
            PG8_LDB(B0, 0, 0); PG8_SCHED; PG8_LDA(At, 0, 0); PG8_STAGE(PG8_SA(1, 1), a1 + hstep, voffA);
            PG8_WAIT_L(8); PG8_BAR; PG8_WAIT_L(0); PG8_MMA(0, 0, At, B0); PG8_BAR; PG8_SCHED;
            PG8_LDB(B1, 0, 1); PG8_STAGE(PG8_SB(0, 0), b2, voffB);
            PG8_BAR; PG8_WAIT_L(0); PG8_MMA(0, 1, At, B1); PG8_BAR;
            PG8_LDA(At, 0, 1); PG8_STAGE(PG8_SA(0, 0), a2, voffA);
            PG8_BAR; PG8_WAIT_L(0); PG8_MMA(1, 0, At, B0); PG8_BAR; PG8_SCHED;
            PG8_STAGE(PG8_SB(0, 1), b2 + hstep, voffB);
            PG8_WAIT_V(6); PG8_BAR; PG8_MMA(1, 1, At, B1); PG8_BAR;
            PG8_LDB(B0, 1, 0); PG8_SCHED; PG8_LDA(At, 1, 0); PG8_STAGE(PG8_SA(0, 1), a2 + hstep, voffA);
            PG8_WAIT_L(8); PG8_BAR; PG8_WAIT_L(0); PG8_MMA(0, 0, At, B0); PG8_BAR; PG8_SCHED;
            PG8_LDB(B1, 1, 1); PG8_STAGE(PG8_SB(1, 0), b3, voffB);
            PG8_BAR; PG8_WAIT_L(0); PG8_MMA(0, 1, At, B1); PG8_BAR;
            PG8_LDA(At, 1, 1); PG8_STAGE(PG8_SA(1, 0), a3, voffA);
            PG8_BAR; PG8_WAIT_L(0); PG8_MMA(1, 0, At, B0); PG8_BAR; PG8_SCHED;
            PG8_STAGE(PG8_SB(1, 1), b3 + hstep, voffB);
            PG8_WAIT_V(6); PG8_BAR; PG8_MMA(1, 1, At, B1); PG8_BAR;
            }
        }
        if constexpr (ALIGN_EPI) { if (wr == 0) PG8_BAR; }
        E(acc, cur, wr, wc, fr, fq);
        if (!has_next) break;
#pragma unroll
        for (int a = 0; a < 2; ++a)
#pragma unroll
            for (int b = 0; b < 2; ++b)
#pragma unroll
                for (int m = 0; m < 4; ++m)
#pragma unroll
                    for (int n = 0; n < 2; ++n) acc[a][b][m][n] = (f32x4){0.f, 0.f, 0.f, 0.f};
        cur = nxt; cA = nA; cB = nB; ++ui;
        if constexpr (ALIGN_EPI) { if (wr == 1) PG8_BAR; }
    }
    PG8_WAIT_V(0);
    if constexpr (!ALIGN_EPI) { if (wr == 0) PG8_BAR; }
    PG8_BAR;
#undef PG8_SA
#undef PG8_SB
#undef PG8_STAGE
#undef PG8_LDA
#undef PG8_LDB
#undef PG8_MMA
#undef PG8_WAIT_V
#undef PG8_WAIT_L
#undef PG8_BAR
#undef PG8_SCHED
}
}


__device__ __forceinline__ size_t img_off(int row, int k, int K) { return ((size_t)(row >> 7) * (size_t)(K >> 6) + (size_t)(k >> 6)) * 16384u + (size_t)pg8::lds_byte(row & 127, k & 63); }
__device__ __forceinline__ size_t img8_off(int row, int k, int K) { return ((size_t)(row >> 7) * (size_t)(K >> 7) + (size_t)(k >> 7)) * 16384u + (size_t)pg8::lds_byte(row & 127, (k & 127) >> 1) + (size_t)(k & 1); }
__device__ __forceinline__ int perm_slot(int n) { const int s = n & 31; return (n & ~31) + 16 * ((s >> 2) & 1) + 4 * (s >> 3) + (s & 3); }
__device__ __forceinline__ unsigned pk2(float lo, float hi) { return pg8::cvt_pk_bf16(lo, hi); }
__device__ __forceinline__ float bflo(unsigned u) { return __uint_as_float(u << 16); }
__device__ __forceinline__ float bfhi(unsigned u) { return __uint_as_float(u & 0xffff0000u); }
__device__ __forceinline__ float bf1(bf16_t b) { return __uint_as_float(((unsigned)b) << 16); }
__device__ __forceinline__ f32x4 unpk4(u32x2 w) { return (f32x4){bflo(w.x), bfhi(w.x), bflo(w.y), bfhi(w.y)}; }
__device__ __forceinline__ u32x2 pack4(f32x4 v) { u32x2 w; w.x = pk2(v[0], v[1]); w.y = pk2(v[2], v[3]); return w; }
__device__ __forceinline__ float wave_sum(float v) {
#pragma unroll
    for (int o = 1; o < 64; o <<= 1) v += __shfl_xor(v, o);
    return v;
}
__device__ __forceinline__ float wave_max(float v) {
#pragma unroll
    for (int o = 1; o < 64; o <<= 1) v = fmaxf(v, __shfl_xor(v, o));
    return v;
}
__device__ __forceinline__ float ex2(float x) { return __builtin_amdgcn_exp2f(x); }
__device__ __forceinline__ float rcp(float x) { return __builtin_amdgcn_rcpf(x); }
__device__ __forceinline__ float sigm(float x) { return rcp(1.0f + ex2(-1.4426950408889634f * x)); }
__device__ __forceinline__ float silu(float x) { return x * sigm(x); }
__device__ __forceinline__ float gelu_t(float x) { const float u = x * (1.0f + 0.044715f * x * x); return x * rcp(1.0f + ex2(-2.3022081982f * u)); }
__device__ __forceinline__ float dot4(f32x4 a, f32x4 b) { return (a[0] * b[0] + a[1] * b[1]) + (a[2] * b[2] + a[3] * b[3]); }
__device__ __forceinline__ float hsum4(f32x4 a) { return (a[0] + a[1]) + (a[2] + a[3]); }
__device__ __forceinline__ float log2gamma(int h) { return log2f(1.0f - exp2f(-5.0f - (float)h)); }

__device__ __forceinline__ int launder(int v) { asm volatile("" : "+v"(v)); return v; }
__device__ __forceinline__ bf16x8 tr_frag(LAS const unsigned char* img, int pitch, int k0, int c0, int lane) {
    const int g = lane >> 4, q = (lane & 15) >> 2, p = lane & 3;
    LAS const unsigned char* a = img + (k0 + 8 * g + q) * pitch + (c0 + 4 * p) * 2;
    const s16x4 lo = __builtin_amdgcn_ds_read_tr16_b64_v4i16((LAS s16x4*)a);
    const s16x4 hi = __builtin_amdgcn_ds_read_tr16_b64_v4i16((LAS s16x4*)(a + 4 * pitch));
    return (bf16x8){lo[0], lo[1], lo[2], lo[3], hi[0], hi[1], hi[2], hi[3]};
}
__device__ __forceinline__ f32x4 mma(f32x4 acc, bf16x8 fcols, bf16x8 frows) { return __builtin_amdgcn_mfma_f32_16x16x32_bf16(fcols, frows, acc, 0, 0, 0); }

#define XB_TMO      128
#define XB_XCNT(j)  (256  + 64 * (j))
#define XB_XSUB(j)  (1280 + 64 * (j))
#define XB_XGEN(j)  (2304 + 64 * (j))
#define XB_TOP      3328
#define XB_TOPGEN   3392
#define XCD_BAR_WORDS 3456
#define XB_SPIN_CAP (1u << 22)
__device__ __forceinline__ unsigned xb_ld(unsigned* p)              { return __hip_atomic_load(p, __ATOMIC_RELAXED, __HIP_MEMORY_SCOPE_AGENT); }
__device__ __forceinline__ unsigned xb_add(unsigned* p, unsigned v) { return __hip_atomic_fetch_add(p, v, __ATOMIC_RELAXED, __HIP_MEMORY_SCOPE_AGENT); }
__device__ __forceinline__ unsigned xb_xcc_id() { return (unsigned)__builtin_amdgcn_s_getreg((3 << 11) | 20) & 0xFu; }
#define XB_SPIN(cond, bar) do { unsigned _sp = 0; while (cond) { __builtin_amdgcn_s_sleep(1); \
    if ((++_sp & 255u) == 0u) { if (xb_ld(&(bar)[XB_TMO])) break; if (_sp > XB_SPIN_CAP) { atomicAdd(&(bar)[XB_TMO], 1u); break; } } } } while (0)
struct XcdBarrier { unsigned* bar; unsigned x; volatile LAS unsigned* st; };
__device__ __forceinline__ XcdBarrier xcd_barrier_post(unsigned* bar, volatile LAS unsigned* st) {
    XcdBarrier b; b.bar = bar; b.x = xb_xcc_id(); b.st = st;
    if (threadIdx.x == 0) (void)xb_add(&bar[XB_XCNT(b.x)], 1u);
    return b;
}
__device__ __forceinline__ void xcd_barrier_complete(unsigned* bar, unsigned x, unsigned& nloc, unsigned& nx) {
    const unsigned G = gridDim.x * gridDim.y * gridDim.z;
    unsigned sum, cnt, mine, sp = 0u;
    for (;;) {
        sum = 0u; cnt = 0u; mine = 0u;
#pragma unroll
        for (unsigned j = 0; j < 16; ++j) { const unsigned c = xb_ld(&bar[XB_XCNT(j)]); sum += c; cnt += (c > 0u) ? 1u : 0u; mine = (j == x) ? c : mine; }
        if (sum == G) break;
        __builtin_amdgcn_s_sleep(1);
        if ((++sp & 255u) == 0u) { if (xb_ld(&bar[XB_TMO])) break; if (sp > XB_SPIN_CAP) { atomicAdd(&bar[XB_TMO], 1u); break; } }
    }
    nloc = mine > 0u ? mine : 1u; nx = cnt > 0u ? cnt : 1u;
}
__device__ __forceinline__ void xcd_barrier(const XcdBarrier& b) {
    asm volatile("s_waitcnt vmcnt(0)" ::: "memory");
    __syncthreads();
    if (threadIdx.x == 0) {
        unsigned* bar = b.bar;
        __builtin_amdgcn_s_waitcnt(0);
        unsigned nloc = b.st[0], nx = b.st[1];
        if (nloc == 0u) { xcd_barrier_complete(bar, b.x, nloc, nx); b.st[0] = nloc; b.st[1] = nx; }
        const unsigned old = xb_add(&bar[XB_XSUB(b.x)], 1u);
        const unsigned gen = old / nloc;
        if (old + 1u == (gen + 1u) * nloc) {
            __builtin_amdgcn_fence(__ATOMIC_RELEASE, "agent");
            asm volatile("s_waitcnt vmcnt(0)" ::: "memory");
            const unsigned og = xb_add(&bar[XB_TOP], 1u);
            const unsigned tg = og / nx;
            if (og + 1u == (tg + 1u) * nx) xb_add(&bar[XB_TOPGEN], 1u);
            else XB_SPIN(xb_ld(&bar[XB_TOPGEN]) == tg, bar);
            __builtin_amdgcn_fence(__ATOMIC_ACQUIRE, "agent");
            xb_add(&bar[XB_XGEN(b.x)], 1u);
            asm volatile("s_waitcnt vmcnt(0)" ::: "memory");
        } else {
            XB_SPIN(xb_ld(&bar[XB_XGEN(b.x)]) == gen, bar);
            __builtin_amdgcn_fence(__ATOMIC_ACQUIRE, "agent");
            asm volatile("s_waitcnt vmcnt(0)" ::: "memory");
        }
    }
    __syncthreads();
}

struct Frame {
    LAS unsigned char* lds;
    int tid, lane, wave, G, cu;
    const float *xp, *xs, *state, *cmk, *cmv, *memp, *g_pre, *w_in, *g_anorm, *w_s, *b_s, *g_ret, *g_mem, *w_mem, *w_oa, *w_ob, *w_oc, *w_out, *g_final;
    float* out; unsigned char* ws;
    bf16_t *WinT, *WmemT, *WoaT, *WobT, *WocT, *WoutT, *H, *MEMN, *Z, *MKV, *RS, *AACT, *BACT, *CACT, *MG;
    float *ropec, *ropes, *statv, *stato, *stats, *SH, *SW; unsigned* CMAX; unsigned char *H8, *W8;
};

template <bool I8> struct EpiZ {
    static constexpr bool PERM = true;
    bf16_t* Z; float* statv; const float* ropec; const float* ropes; const float* sh; const float* sw;
    template <int ACT> __device__ __forceinline__ void ew(const f32x4 (&acc)[2][2][4][2], int pn, int row0, int wc, int fq) const {
        bf16_t* zb = Z + (size_t)pn * 256 + wc * 32 + 8 * fq;
#pragma unroll
        for (int ai = 0; ai < 2; ++ai)
#pragma unroll
            for (int m = 0; m < 4; ++m) { const size_t row = (size_t)(row0 + ai * 128 + m * 16); float s = 0.f, q = 0.f;
#pragma unroll
                for (int bj = 0; bj < 2; ++bj) { f32x4 v0 = acc[ai][bj][m][0], v1 = acc[ai][bj][m][1];
#pragma unroll
                    for (int e = 0; e < 4; ++e) {
                        if (ACT == 1 || ACT == 2) { v0[e] = gelu_t(v0[e]); v1[e] = gelu_t(v1[e]); }
                        if (ACT == 3) { v0[e] = silu(v0[e]); v1[e] = silu(v1[e]); }
                        if (ACT == 4) { v0[e] = v0[e] * 0.0625f; v1[e] = v1[e] * 0.0625f; }
                        if (ACT == 5) { v0[e] = sigm(v0[e]); v1[e] = sigm(v1[e]); } }
                    if (ACT == 2) { s += hsum4(v0) + hsum4(v1); q += dot4(v0, v0) + dot4(v1, v1); }
                    u32x4 w; w.x = pk2(v0[0], v0[1]); w.y = pk2(v0[2], v0[3]); w.z = pk2(v1[0], v1[1]); w.w = pk2(v1[2], v1[3]);
                    *(u32x4*)(zb + row * LDZ + bj * 128) = w; }
                if (ACT == 2) { s += __shfl_xor(s, 16); s += __shfl_xor(s, 32); q += __shfl_xor(q, 16); q += __shfl_xor(q, 32);
                    if (fq == 0) *(f32x2*)(statv + (row * 32 + (pn - 8) * 4 + wc) * 2) = (f32x2){s, q}; } }
    }
    __device__ __forceinline__ void rot(const f32x4 (&acc)[2][2][4][2], int pn, int row0, int wc, int fq) const {
        const float sc = (pn >= 32) ? 0.0625f : 1.0f; bf16_t* zb = Z + (size_t)pn * 256 + wc * 32 + 8 * fq;
#pragma unroll
        for (int ai = 0; ai < 2; ++ai)
#pragma unroll
            for (int m = 0; m < 4; ++m) { const int row = row0 + ai * 128 + m * 16; const int p = row < MP ? (row & 2047) : 2048; const size_t ti = (size_t)p * 128 + wc * 32 + 8 * fq;
                const f32x4 c0 = *(const f32x4*)(ropec + ti) * sc, c1 = *(const f32x4*)(ropec + ti + 4) * sc, s0 = *(const f32x4*)(ropes + ti) * sc, s1 = *(const f32x4*)(ropes + ti + 4) * sc;
                const f32x4 a0 = acc[ai][0][m][0], a1 = acc[ai][0][m][1], b0 = acc[ai][1][m][0], b1 = acc[ai][1][m][1];
                const f32x4 x0 = a0 * c0 - b0 * s0, x1 = a1 * c1 - b1 * s1, y0 = a0 * s0 + b0 * c0, y1 = a1 * s1 + b1 * c1;
                u32x4 w; w.x = pk2(x0[0], x0[1]); w.y = pk2(x0[2], x0[3]); w.z = pk2(x1[0], x1[1]); w.w = pk2(x1[2], x1[3]);
                *(u32x4*)(zb + (size_t)row * LDZ) = w;
                w.x = pk2(y0[0], y0[1]); w.y = pk2(y0[2], y0[3]); w.z = pk2(y1[0], y1[1]); w.w = pk2(y1[2], y1[3]);
                *(u32x4*)(zb + (size_t)row * LDZ + 128) = w;
                asm volatile("" ::: "memory"); }
    }
    __device__ __forceinline__ void operator()(f32x4 (&acc)[2][2][4][2], const pg8::Unit& u, int wr, int wc, int fr, int fq) const {
        const int row0 = u.pm * 256 + wr * 64 + fr;
        const int pn = I8 ? (u.pn < 32 ? u.pn : u.pn + 16) : u.pn;
        if (I8) {
            if (u.pm == 32 && pn >= 8 && pn < 16) return;
            const int col0 = pn * 256 + wc * 32 + 8 * fq; f32x4 swv[2][2];
#pragma unroll
            for (int bj = 0; bj < 2; ++bj)
#pragma unroll
                for (int n = 0; n < 2; ++n) swv[bj][n] = *(const f32x4*)(sw + col0 + bj * 128 + 4 * n);
#pragma unroll
            for (int ai = 0; ai < 2; ++ai)
#pragma unroll
                for (int m = 0; m < 4; ++m) { const float hs = sh[row0 + ai * 128 + m * 16];
#pragma unroll
                    for (int bj = 0; bj < 2; ++bj)
#pragma unroll
                        for (int n = 0; n < 2; ++n) { const i32x4 q = __builtin_bit_cast(i32x4, acc[ai][bj][m][n]);
                            acc[ai][bj][m][n] = (f32x4){(float)q[0], (float)q[1], (float)q[2], (float)q[3]} * (swv[bj][n] * hs); } }
        }
        if (pn < 8) ew<1>(acc, pn, row0, wc, fq);
        else if (pn < 16) ew<2>(acc, pn, row0, wc, fq);
        else if (pn < 24 || (pn >= 48 && pn < 56) || (pn >= 60 && pn < 64)) ew<3>(acc, pn, row0, wc, fq);
        else if (pn < 40) rot(acc, pn, row0, wc, fq);
        else if (pn < 48) ew<0>(acc, pn, row0, wc, fq);
        else if (pn < 60) ew<4>(acc, pn, row0, wc, fq);
        else ew<5>(acc, pn, row0, wc, fq);
    }
};
struct EpiMem {
    static constexpr bool PERM = true;
    float* omk; float* omv; bf16_t* mkv;
    __device__ __forceinline__ void operator()(f32x4 (&acc)[2][2][4][2], const pg8::Unit& u, int wr, int wc, int fr, int fq) const {
        const int row0 = u.pm * 256 + wr * 64 + fr;
        const int colt = u.pn * 256 + wc * 32 + 8 * fq; float* ob = (u.pn < 4) ? omk : omv; const int cc = colt & 1023;
#pragma unroll
        for (int ai = 0; ai < 2; ++ai)
#pragma unroll
            for (int m = 0; m < 4; ++m) { const size_t row = (size_t)(row0 + ai * 128 + m * 16);
#pragma unroll
                for (int bj = 0; bj < 2; ++bj) { const f32x4 v0 = acc[ai][bj][m][0], v1 = acc[ai][bj][m][1];
                    *(f32x4*)(ob + row * 1024 + cc + bj * 128) = v0; *(f32x4*)(ob + row * 1024 + cc + bj * 128 + 4) = v1;
                    u32x4 w; w.x = pk2(v0[0], v0[1]); w.y = pk2(v0[2], v0[3]); w.z = pk2(v1[0], v1[1]); w.w = pk2(v1[2], v1[3]);
                    *(u32x4*)(mkv + row * 2048 + colt + bj * 128) = w; } }
    }
};
struct EpiMerge {
    static constexpr bool PERM = true;
    const bf16_t* Z; bf16_t* MG; int pass;
    __device__ __forceinline__ void operator()(f32x4 (&acc)[2][2][4][2], const pg8::Unit& u, int wr, int wc, int fr, int fq) const {
        const int row0 = u.pm * 256 + wr * 64 + fr, col0 = u.pn * 256 + wc * 32 + 8 * fq;
#pragma unroll
        for (int ai = 0; ai < 2; ++ai)
#pragma unroll
            for (int m = 0; m < 4; ++m) { const size_t row = (size_t)(row0 + ai * 128 + m * 16);
#pragma unroll
                for (int bj = 0; bj < 2; ++bj) { const int c = col0 + bj * 128;
                    const u32x4 g = *(const u32x4*)(Z + row * LDZ + ZC_GS + pass * D + c);
                    f32x4 v0 = acc[ai][bj][m][0] * (f32x4){bflo(g.x), bfhi(g.x), bflo(g.y), bfhi(g.y)}, v1 = acc[ai][bj][m][1] * (f32x4){bflo(g.z), bfhi(g.z), bflo(g.w), bfhi(g.w)};
                    if (pass) { const u32x4 p = *(const u32x4*)(MG + row * D + c); v0 += (f32x4){bflo(p.x), bfhi(p.x), bflo(p.y), bfhi(p.y)}; v1 += (f32x4){bflo(p.z), bfhi(p.z), bflo(p.w), bfhi(p.w)}; }
                    u32x4 w; w.x = pk2(v0[0], v0[1]); w.y = pk2(v0[2], v0[3]); w.z = pk2(v1[0], v1[1]); w.w = pk2(v1[2], v1[3]);
                    *(u32x4*)(MG + row * D + c) = w; } }
    }
};
struct EpiOut {
    static constexpr bool PERM = false;
    const float* X; float* Y; float* stato;
    __device__ __forceinline__ void operator()(f32x4 (&acc)[2][2][4][2], const pg8::Unit& u, int wr, int wc, int fr, int fq) const {
        const int row0 = u.pm * 256 + wr * 64 + fr, col0 = u.pn * 256 + wc * 32 + 4 * fq;
#pragma unroll
        for (int ai = 0; ai < 2; ++ai)
#pragma unroll
            for (int m = 0; m < 4; ++m) { const size_t row = (size_t)(row0 + ai * 128 + m * 16); float q = 0.f;
#pragma unroll
                for (int bj = 0; bj < 2; ++bj)
#pragma unroll
                    for (int n = 0; n < 2; ++n) { const size_t o = row * D + col0 + bj * 128 + n * 16; const f32x4 v = *(const f32x4*)(X + o) + acc[ai][bj][m][n]; *(f32x4*)(Y + o) = v; q += dot4(v, v); }
                q += __shfl_xor(q, 16); q += __shfl_xor(q, 32);
                if (fq == 0) stato[row * 64 + u.pn * 4 + wc] = q; }
    }
};

__device__ __forceinline__ void p0_load_tile(float (&v)[32], const float* W, int N, int k0, int n0, int lane) {
    const float* src = W + (size_t)(k0 + (lane >> 5)) * N + n0 + (lane & 31);
#pragma unroll
    for (int i = 0; i < 32; ++i) v[i] = __builtin_nontemporal_load(src + (size_t)(2 * i) * N);
}
template <int MODE> __device__ __forceinline__ void p0_transpose_tile(const float* W, int K, int N, int k0, int n0, bf16_t* WT, int nd0, LAS float* scr, int lane) {
    float v[32]; p0_load_tile(v, W, N, k0, n0, lane);
#pragma unroll
    for (int i = 0; i < 32; ++i) scr[(2 * i + (lane >> 5)) * 33 + (lane & 31)] = v[i];
    LDS_WAIT();
    const int c = lane & 7;
#pragma unroll
    for (int j = 0; j < 4; ++j) { const int n = (lane >> 3) + 8 * j; const LAS float* s = scr + (8 * c) * 33 + n;
        u32x4 o; o.x = pk2(s[0 * 33], s[1 * 33]); o.y = pk2(s[2 * 33], s[3 * 33]); o.z = pk2(s[4 * 33], s[5 * 33]); o.w = pk2(s[6 * 33], s[7 * 33]);
        if (MODE == 0) *(u32x4*)(WT + (size_t)(nd0 + n) * K + k0 + 8 * c) = o;
        else { const int nn = nd0 + n; *(u32x4*)((unsigned char*)WT + img_off(MODE == 2 ? perm_slot(nn) : nn, k0 + 8 * c, K)) = o; } }
    LDS_WAIT();
}
template <int MODE> __device__ __forceinline__ void p0_transpose_item(const float* W, int K, int N, bf16_t* WT, LAS float* scr, int item, int lane) {
    const int nblk = N / 32, kb = item / nblk, nb = item % nblk; p0_transpose_tile<MODE>(W, K, N, 64 * kb, 32 * nb, WT, 32 * nb, scr, lane);
}
__device__ __forceinline__ int i8_col0(int nb8) { return nb8 < 256 ? nb8 * 32 : nb8 * 32 + 4096; }
__device__ __forceinline__ void p0_absmax_item(const Frame& F, int item, int lane) {
    const int kb = item / 768, nb8 = item % 768, n0 = i8_col0(nb8);
    float v[32]; p0_load_tile(v, F.w_in, NIN, 64 * kb, n0, lane); float m = 0.f;
#pragma unroll
    for (int i = 0; i < 32; ++i) m = fmaxf(m, fabsf(v[i]));
    m = fmaxf(m, __shfl_xor(m, 32));
    if (lane < 32) atomicMax(F.CMAX + n0 + lane, __float_as_uint(m));
}
__device__ __forceinline__ void p0_quant_item(const Frame& F, LAS float* scr, int item, int lane) {
    const int kb = item / 768, nb8 = item % 768, n0 = i8_col0(nb8), k0 = 64 * kb;
    float v[32]; p0_load_tile(v, F.w_in, NIN, k0, n0, lane);
    const float amax = __uint_as_float(F.CMAX[n0 + (lane & 31)]); const float sc = amax > 0.f ? 127.0f / amax : 0.f;
    if (kb == 0 && lane < 32) F.SW[n0 + lane] = amax * (1.0f / 127.0f);
    LAS int* si = (LAS int*)scr;
#pragma unroll
    for (int i = 0; i < 32; ++i) si[(2 * i + (lane >> 5)) * 33 + (lane & 31)] = (int)__builtin_rintf(v[i] * sc);
    LDS_WAIT();
    const int c = lane & 7;
#pragma unroll
    for (int j = 0; j < 4; ++j) { const int n = (lane >> 3) + 8 * j; const LAS int* q = si + (8 * c) * 33 + n;
        u32x2 o; o.x = (unsigned)(q[0] & 0xff) | ((unsigned)(q[33] & 0xff) << 8) | ((unsigned)(q[66] & 0xff) << 16) | ((unsigned)(q[99] & 0xff) << 24);
        o.y = (unsigned)(q[132] & 0xff) | ((unsigned)(q[165] & 0xff) << 8) | ((unsigned)(q[198] & 0xff) << 16) | ((unsigned)(q[231] & 0xff) << 24);
        *(u32x2*)(F.W8 + img8_off(perm_slot(nb8 * 32 + n), k0 + 8 * c, D)) = o; }
    LDS_WAIT();
}
template <bool Q8> __device__ __forceinline__ void rms_row(const float* xrow, const float* g, bf16_t* obase, int m, int lane, unsigned char* o8, float* sh) {
    const f32x4* xr = (const f32x4*)xrow + lane; f32x4 v[16]; float s = 0.f;
#pragma unroll
    for (int j = 0; j < 16; ++j) { v[j] = xr[64 * j]; s += dot4(v[j], v[j]); }
    const float r = 1.0f / sqrtf(wave_sum(s) * (1.0f / 4096.0f) + EPS);
    const f32x4* gr = (const f32x4*)g + lane; float am = 0.f;
#pragma unroll
    for (int j = 0; j < 16; ++j) { v[j] = v[j] * r * gr[64 * j]; *(u32x2*)((unsigned char*)obase + img_off(m, 4 * lane + 256 * j, D)) = pack4(v[j]);
        if (Q8) am = fmaxf(am, fmaxf(fmaxf(fabsf(v[j][0]), fabsf(v[j][1])), fmaxf(fabsf(v[j][2]), fabsf(v[j][3])))); }
    if (Q8) { am = wave_max(am); const float sc = am > 0.f ? 127.0f / am : 0.f; if (lane == 0) sh[m] = am * (1.0f / 127.0f);
#pragma unroll
        for (int j = 0; j < 16; ++j) { const int q0 = (int)__builtin_rintf(v[j][0] * sc), q1 = (int)__builtin_rintf(v[j][1] * sc), q2 = (int)__builtin_rintf(v[j][2] * sc), q3 = (int)__builtin_rintf(v[j][3] * sc);
            *(unsigned*)(o8 + img8_off(m, 4 * lane + 256 * j, D)) = (unsigned)(q0 & 0xff) | ((unsigned)(q1 & 0xff) << 8) | ((unsigned)(q2 & 0xff) << 16) | ((unsigned)(q3 & 0xff) << 24); } }
}
__device__ __forceinline__ void p0a_prologue(const Frame& F) {
    LAS float* scr = (LAS float*)(F.lds + F.wave * 8448);
    const int gw = F.cu * 8 + F.wave, NGW = F.G * 8;
    constexpr int I_AMAX = 64 * 768, I_STR = 64 * 192, I_MEM = (D / 64) * (2048 / 32), I_OA = (AW / 64) * (D / 32), I_OB = (RW / 64) * (D / 32), I_OC = (MW / 64) * (D / 32), I_OUT = (D / 64) * (D / 32);
    constexpr int NITEMS = I_AMAX + I_STR + I_MEM + I_OA + I_OB + I_OC + I_OUT;
    for (int it = gw; it < NITEMS; it += NGW) {
        int r = it;
        if (r < I_AMAX) { p0_absmax_item(F, r, F.lane); continue; } r -= I_AMAX;
        if (r < I_STR) { const int kb = r / 192, nb = r % 192; const int n0 = nb < 64 ? 2048 + nb * 32 : 8192 + (nb - 64) * 32;
            p0_transpose_tile<2>(F.w_in, D, NIN, 64 * kb, n0, F.WinT, n0, scr, F.lane); continue; } r -= I_STR;
        if (r < I_MEM) { p0_transpose_item<2>(F.w_mem, D, 2048, F.WmemT, scr, r, F.lane); continue; } r -= I_MEM;
        if (r < I_OA) { p0_transpose_item<0>(F.w_oa, AW, D, F.WoaT, scr, r, F.lane); continue; } r -= I_OA;
        if (r < I_OB) { p0_transpose_item<0>(F.w_ob, RW, D, F.WobT, scr, r, F.lane); continue; } r -= I_OB;
        if (r < I_OC) { p0_transpose_item<0>(F.w_oc, MW, D, F.WocT, scr, r, F.lane); continue; } r -= I_OC;
        p0_transpose_item<0>(F.w_out, D, D, F.WoutT, scr, r, F.lane);
    }
    for (int m = gw; m < MPAD + 1024; m += NGW) {
        if (m < MP) rms_row<true>(F.xp + (size_t)m * D, F.g_pre, F.H, m, F.lane, F.H8, F.SH);
        else if (m < MREAL) rms_row<true>(F.xs + (size_t)(m - MP) * D, F.g_pre, F.H, m, F.lane, F.H8, F.SH);
        else if (m < MPAD) { u32x4* o = (u32x4*)((unsigned char*)F.H + (size_t)(MREAL >> 7) * 64 * 16384 + (size_t)(m - MREAL) * 8192) + F.lane;
#pragma unroll
            for (int j = 0; j < 8; ++j) o[64 * j] = (u32x4){0u, 0u, 0u, 0u};
            u32x4* o2 = (u32x4*)(F.H8 + (size_t)(MREAL >> 7) * 32 * 16384 + (size_t)(m - MREAL) * 4096) + F.lane;
#pragma unroll
            for (int j = 0; j < 4; ++j) o2[64 * j] = (u32x4){0u, 0u, 0u, 0u};
            if (F.lane == 0) F.SH[m] = 0.f; }
        else rms_row<false>(F.memp + (size_t)(m - MPAD) * D, F.g_mem, F.MEMN, m - MPAD, F.lane, nullptr, nullptr);
    }
    for (int idx = F.cu * 512 + F.tid; idx < 2049 * 128; idx += F.G * 512) {
        const int p = idx >> 7, j = idx & 127; const int pos = p < 2048 ? p : 16384;
        double iv = 1.0, bs = 0.9305720409296989; for (int e = j; e > 0; e >>= 1) { if (e & 1) iv *= bs; bs *= bs; }
        const float inv = (float)iv; const float ang = (float)pos * inv;
        const double x = (double)ang; const double n = __builtin_rint(x * 0.15915494309189535);
        const double r = __builtin_fma(-n, 2.4492935982947064e-16, __builtin_fma(-n, 6.283185307179586, x)); const double r2 = r * r;
        double sn = r, tm = r, cs = 1.0, tc = 1.0;
#pragma unroll
        for (int k = 1; k <= 13; ++k) { tm *= -r2 * (1.0 / (double)((2 * k) * (2 * k + 1))); sn += tm; tc *= -r2 * (1.0 / (double)((2 * k - 1) * (2 * k))); cs += tc; }
        F.ropec[idx] = (float)cs; F.ropes[idx] = (float)sn;
    }
}

template <int NROWS>
__device__ __forceinline__ void stage_tile256(LAS unsigned char* img, const bf16_t* src, size_t ld, int tid) {
    constexpr int PER = NROWS * 32 / 512;
#pragma unroll
    for (int b0 = 0; b0 < PER; b0 += 8) {
        u32x4 v[8];
#pragma unroll
        for (int i = 0; i < 8; ++i) { const int ch = tid + 512 * (b0 + i), row = ch >> 5, cc = ch & 31; v[i] = *(const u32x4*)(src + (size_t)row * ld + cc * 8); }
#pragma unroll
        for (int i = 0; i < 8; ++i) { const int ch = tid + 512 * (b0 + i), row = ch >> 5, cc = ch & 31; *(LAS u32x4*)(img + row * IMG_PITCH + cc * 16) = v[i]; }
    }
}

__device__ __forceinline__ void scan_unit(const Frame& F, int b, int h, int sl) {
    LAS unsigned char* imgK = F.lds; LAS unsigned char* imgV = F.lds + 67584;
    const int w = F.wave, tid = launder(F.tid), lane = tid & 63, fr = lane & 15, fq = lane >> 4;
    const float l2g = log2gamma(h); const float dblk = ex2(128.0f * l2g);
    f32x4 acc[2][2];
#pragma unroll
    for (int a = 0; a < 2; ++a)
#pragma unroll
        for (int k = 0; k < 2; ++k) acc[a][k] = (f32x4){0.f, 0.f, 0.f, 0.f};
    for (int c = 0; c < 16; ++c) {
        const size_t r0 = (size_t)b * 2048 + c * 128;
        __syncthreads();
        stage_tile256<128>(imgK, F.Z + r0 * LDZ + ZC_K + h * 256, LDZ, tid);
        { const int j = tid >> 2, cc = tid & 3; const u32x4 raw = *(const u32x4*)(F.Z + (r0 + j) * LDZ + ZC_RV + h * 256 + sl * 32 + cc * 8);
          const float sc = ex2((float)(127 - j) * l2g);
          u32x4 o; o.x = pk2(bflo(raw.x) * sc, bfhi(raw.x) * sc); o.y = pk2(bflo(raw.y) * sc, bfhi(raw.y) * sc); o.z = pk2(bflo(raw.z) * sc, bfhi(raw.z) * sc); o.w = pk2(bflo(raw.w) * sc, bfhi(raw.w) * sc);
          *(LAS u32x4*)(imgV + j * 80 + cc * 16) = o; }
        __syncthreads();
#pragma unroll
        for (int a = 0; a < 2; ++a)
#pragma unroll
            for (int k = 0; k < 2; ++k) acc[a][k] = acc[a][k] * dblk;
#pragma unroll
        for (int s = 0; s < 4; ++s) {
            bf16x8 fv[2], fk[2];
#pragma unroll
            for (int a = 0; a < 2; ++a) { fv[a] = tr_frag(imgV, 80, 32 * s, 16 * a, lane); fk[a] = tr_frag(imgK, IMG_PITCH, 32 * s, 32 * w + 16 * a, lane); }
#pragma unroll
            for (int a = 0; a < 2; ++a)
#pragma unroll
                for (int k = 0; k < 2; ++k) acc[a][k] = mma(acc[a][k], fk[k], fv[a]);
        }
        if (c < 15) {
            bf16_t* rs = F.RS + ((size_t)(b * 8 + h) * 15 + c) * 65536;
#pragma unroll
            for (int a = 0; a < 2; ++a)
#pragma unroll
                for (int k = 0; k < 2; ++k) *(u32x2*)(rs + (size_t)(sl * 32 + 16 * a + fr) * 256 + 32 * w + 16 * k + 4 * fq) = pack4(acc[a][k]);
        }
    }
    float* rp = F.out + O_RP + (size_t)(b * 8 + h) * 65536;
#pragma unroll
    for (int a = 0; a < 2; ++a)
#pragma unroll
        for (int k = 0; k < 2; ++k)
#pragma unroll
            for (int e = 0; e < 4; ++e) rp[(size_t)(32 * w + 16 * k + 4 * fq + e) * 256 + sl * 32 + 16 * a + fr] = acc[a][k][e];
}

__device__ __forceinline__ void spatial_unit(const Frame& F, int b, int c, int g, int hf) {
    LAS unsigned char* img = F.lds; LAS float* st = (LAS float*)(F.lds + SMALL_OFF);
    const int w = F.wave, tid = launder(F.tid), lane = tid & 63, fr = lane & 15, fq = lane >> 4;
    const size_t r0 = (size_t)b * 2048 + c * 128; const int ch0 = g * 512 + hf * 256;
    __syncthreads();
    if (tid < 128) { const f32x4* p = (const f32x4*)(F.statv + (r0 + tid) * 64); float s = 0.f, q = 0.f;
#pragma unroll
        for (int k = 0; k < 16; ++k) { const f32x4 t = p[k]; s += t[0] + t[2]; q += t[1] + t[3]; }
        const float mu = s * (1.0f / 2048.0f); const float var = fmaxf(q * (1.0f / 2048.0f) - mu * mu, 0.f);
        st[2 * tid] = mu; st[2 * tid + 1] = 1.0f / sqrtf(var + EPS); }
    __syncthreads();
#pragma unroll
    for (int i = 0; i < 8; ++i) { const int chk = tid + 512 * i, row = chk >> 5, cc = chk & 31;
        const u32x4 raw = *(const u32x4*)(F.Z + (r0 + row) * LDZ + ZC_V + ch0 + cc * 8);
        const f32x4 ga = *(const f32x4*)(F.g_anorm + ch0 + cc * 8), gb = *(const f32x4*)(F.g_anorm + ch0 + cc * 8 + 4);
        const float mu = st[2 * row], rs = st[2 * row + 1];
        u32x4 o; o.x = pk2((bflo(raw.x) - mu) * rs * ga[0], (bfhi(raw.x) - mu) * rs * ga[1]); o.y = pk2((bflo(raw.y) - mu) * rs * ga[2], (bfhi(raw.y) - mu) * rs * ga[3]);
        o.z = pk2((bflo(raw.z) - mu) * rs * gb[0], (bfhi(raw.z) - mu) * rs * gb[1]); o.w = pk2((bflo(raw.w) - mu) * rs * gb[2], (bfhi(raw.w) - mu) * rs * gb[3]);
        *(LAS u32x4*)(img + row * IMG_PITCH + cc * 16) = o; }
    __syncthreads();
    const int i = 16 * w + fr;
    bf16x8 fw[4];
#pragma unroll
    for (int s = 0; s < 4; ++s) { const int j0 = 32 * s + 8 * fq; const float* wp = F.w_s + (size_t)g * 16384 + i * 128 + j0; const f32x4 a = *(const f32x4*)wp, bq = *(const f32x4*)(wp + 4);
        float t[8] = {a[0], a[1], a[2], a[3], bq[0], bq[1], bq[2], bq[3]};
#pragma unroll
        for (int e = 0; e < 8; ++e) t[e] = (j0 + e <= i) ? t[e] : 0.f;
        const unsigned p0 = pk2(t[0], t[1]), p1 = pk2(t[2], t[3]), p2 = pk2(t[4], t[5]), p3 = pk2(t[6], t[7]);
        const u32x4 pw = (u32x4){p0, p1, p2, p3}; fw[s] = __builtin_bit_cast(bf16x8, pw); }
    f32x4 acc[16];
#pragma unroll
    for (int n = 0; n < 16; ++n) acc[n] = (f32x4){0.f, 0.f, 0.f, 0.f};
    const int smax = w >> 1;
#pragma unroll
    for (int s = 0; s < 4; ++s) if (s <= smax) {
#pragma unroll
        for (int n = 0; n < 16; ++n) { acc[n] = mma(acc[n], tr_frag(img, IMG_PITCH, 32 * s, 16 * n, lane), fw[s]); if ((n & 3) == 3) __builtin_amdgcn_sched_barrier(0); }
    }
    const float bsv = F.b_s[g * 128 + i]; const bf16_t* zr = F.Z + (r0 + i) * LDZ; bf16_t* ar = F.AACT + (r0 + i) * AW;
#pragma unroll
    for (int n = 0; n < 16; ++n) { const int ch = ch0 + 16 * n + 4 * fq;
        const f32x4 uu = unpk4(*(const u32x2*)(zr + ZC_U + ch)), ag = unpk4(*(const u32x2*)(zr + ZC_G + ch));
        *(u32x2*)(ar + ch) = pack4(uu * (acc[n] + bsv) * ag); }
}
__device__ __forceinline__ void spatial_sample_row(const Frame& F, int s) {
    const int lane = launder(F.lane); const size_t row = (size_t)MP + s;
    float sm = 0.f, sq = 0.f; if (lane < 32) { const f32x2 t = *(const f32x2*)(F.statv + (row * 32 + lane) * 2); sm = t[0]; sq = t[1]; }
    sm = wave_sum(sm); sq = wave_sum(sq);
    const float mu = sm * (1.0f / 2048.0f); const float rs = 1.0f / sqrtf(fmaxf(sq * (1.0f / 2048.0f) - mu * mu, 0.f) + EPS);
    const bf16_t* zr = F.Z + row * LDZ;
#pragma unroll
    for (int g = 0; g < 4; ++g) { const int ch = g * 512 + lane * 8;
        const u32x4 rv = *(const u32x4*)(zr + ZC_V + ch), ru = *(const u32x4*)(zr + ZC_U + ch), rg = *(const u32x4*)(zr + ZC_G + ch);
        const f32x4 ga = *(const f32x4*)(F.g_anorm + ch), gb = *(const f32x4*)(F.g_anorm + ch + 4);
        const f32x4 v0 = ((f32x4){bflo(rv.x), bfhi(rv.x), bflo(rv.y), bfhi(rv.y)} - mu) * rs * ga, v1 = ((f32x4){bflo(rv.z), bfhi(rv.z), bflo(rv.w), bfhi(rv.w)} - mu) * rs * gb;
        *(f32x4*)(F.out + O_GV + (size_t)s * AW + ch) = v0; *(f32x4*)(F.out + O_GV + (size_t)s * AW + ch + 4) = v1;
        const float w00 = F.w_s[g * 16384], b0 = F.b_s[g * 128];
        const f32x4 a0 = (f32x4){bflo(ru.x), bfhi(ru.x), bflo(ru.y), bfhi(ru.y)} * (v0 * w00 + b0) * (f32x4){bflo(rg.x), bfhi(rg.x), bflo(rg.y), bfhi(rg.y)};
        const f32x4 a1 = (f32x4){bflo(ru.z), bfhi(ru.z), bflo(ru.w), bfhi(ru.w)} * (v1 * w00 + b0) * (f32x4){bflo(rg.z), bfhi(rg.z), bflo(rg.w), bfhi(rg.w)};
        u32x4 o; o.x = pk2(a0[0], a0[1]); o.y = pk2(a0[2], a0[3]); o.z = pk2(a1[0], a1[1]); o.w = pk2(a1[2], a1[3]);
        *(u32x4*)(F.AACT + row * AW + ch) = o; }
}
__device__ __forceinline__ void ret_sample_item(const Frame& F, int req, int h) {
    LAS float* qs = (LAS float*)F.lds; LAS float* ks = qs + 256; LAS float* red = qs + 512;
    const int w = F.wave, tid = launder(F.tid), lane = tid & 63; const size_t row = (size_t)MP + req; const bf16_t* zr = F.Z + row * LDZ;
    __syncthreads();
    if (tid < 256) { qs[tid] = bf1(zr[ZC_Q + h * 256 + tid]); ks[tid] = bf1(zr[ZC_K + h * 256 + tid]); }
    const f32x4 vv = unpk4(*(const u32x2*)(zr + ZC_RV + h * 256 + lane * 4));
    __syncthreads();
    const float gam = 1.0f - ex2(-5.0f - (float)h);
    const size_t base = ((size_t)(req * 8 + h) * 256) * 256 + lane * 4; const float* sp = F.state + base; float* op = F.out + O_RS + base;
    f32x4 o = (f32x4){0.f, 0.f, 0.f, 0.f};
#pragma unroll
    for (int i0 = 0; i0 < 4; ++i0) { f32x4 R[8];
#pragma unroll
        for (int j = 0; j < 8; ++j) { const int d = w + 8 * (i0 * 8 + j); R[j] = __builtin_nontemporal_load((const f32x4*)(sp + (size_t)d * 256)); }
#pragma unroll
        for (int j = 0; j < 8; ++j) { const int d = w + 8 * (i0 * 8 + j); const f32x4 rn = R[j] * gam + vv * ks[d]; __builtin_nontemporal_store(rn, (f32x4*)(op + (size_t)d * 256)); o += rn * qs[d]; } }
    *(LAS f32x4*)(red + w * 256 + lane * 4) = o;
    __syncthreads();
    if (w == 0) { f32x4 t = *(LAS f32x4*)(red + lane * 4);
#pragma unroll
        for (int k = 1; k < 8; ++k) t += *(LAS f32x4*)(red + k * 256 + lane * 4);
        const float mean = wave_sum(hsum4(t)) * (1.0f / 256.0f); const f32x4 d = t - mean; const float var = wave_sum(dot4(d, d)) * (1.0f / 256.0f); const float rs = 1.0f / sqrtf(var + EPS);
        const f32x4 gr = *(const f32x4*)(F.g_ret + h * 256 + lane * 4), rg = unpk4(*(const u32x2*)(zr + ZC_RG + h * 256 + lane * 4));
        *(u32x2*)(F.BACT + row * RW + h * 256 + lane * 4) = pack4(d * rs * gr * rg); }
}
__device__ __forceinline__ void xattn_sample_item(const Frame& F, int req, int mh) {
    LAS float* cq = (LAS float*)F.lds; LAS float* sc = cq + 256; LAS float* red = cq + 512; LAS float* misc = cq + 512 + 2048;
    const int w = F.wave, tid = launder(F.tid), lane = tid & 63; const size_t row = (size_t)MP + req; const bf16_t* zr = F.Z + row * LDZ;
    __syncthreads();
    if (tid < 256) cq[tid] = bf1(zr[ZC_CQ + mh * 256 + tid]);
    __syncthreads();
    { const int sub = lane >> 4, li = lane & 15; f32x4 cqr[4];
#pragma unroll
      for (int c = 0; c < 4; ++c) cqr[c] = *(LAS f32x4*)(cq + 4 * (li + 16 * c));
#pragma unroll
      for (int g0 = 0; g0 < 8; g0 += 4) { f32x4 kk[4][4];
#pragma unroll
          for (int g = 0; g < 4; ++g) { const int m = 32 * w + 4 * (g0 + g) + sub; const float* kp = F.cmk + (((size_t)req * 256 + m) * 4 + mh) * 256;
#pragma unroll
              for (int c = 0; c < 4; ++c) kk[g][c] = __builtin_nontemporal_load((const f32x4*)(kp + 4 * (li + 16 * c))); }
#pragma unroll
          for (int g = 0; g < 4; ++g) { float dsum = (dot4(kk[g][0], cqr[0]) + dot4(kk[g][1], cqr[1])) + (dot4(kk[g][2], cqr[2]) + dot4(kk[g][3], cqr[3]));
              dsum += __shfl_xor(dsum, 1); dsum += __shfl_xor(dsum, 2); dsum += __shfl_xor(dsum, 4); dsum += __shfl_xor(dsum, 8);
              if (li == 0) sc[32 * w + 4 * (g0 + g) + sub] = dsum; } } }
    __syncthreads();
    if (w == 0) { f32x4 s4 = *(LAS f32x4*)(sc + 4 * lane); const float mx = wave_max(fmaxf(fmaxf(s4[0], s4[1]), fmaxf(s4[2], s4[3])));
#pragma unroll
        for (int e = 0; e < 4; ++e) s4[e] = ex2((s4[e] - mx) * 1.4426950408889634f);
        const float sum = wave_sum(hsum4(s4)); *(LAS f32x4*)(sc + 4 * lane) = s4; if (lane == 0) misc[0] = 1.0f / sum; }
    __syncthreads();
    f32x4 o = (f32x4){0.f, 0.f, 0.f, 0.f};
#pragma unroll
    for (int i0 = 0; i0 < 4; ++i0) { f32x4 V[8];
#pragma unroll
        for (int j = 0; j < 8; ++j) { const int m = w + 8 * (i0 * 8 + j); V[j] = __builtin_nontemporal_load((const f32x4*)(F.cmv + (((size_t)req * 256 + m) * 4 + mh) * 256 + lane * 4)); }
#pragma unroll
        for (int j = 0; j < 8; ++j) { const int m = w + 8 * (i0 * 8 + j); o += V[j] * sc[m]; } }
    *(LAS f32x4*)(red + w * 256 + lane * 4) = o;
    __syncthreads();
    if (w == 0) { f32x4 t = *(LAS f32x4*)(red + lane * 4);
#pragma unroll
        for (int k = 1; k < 8; ++k) t += *(LAS f32x4*)(red + k * 256 + lane * 4);
        const f32x4 cg = unpk4(*(const u32x2*)(zr + ZC_CG + mh * 256 + lane * 4));
        *(u32x2*)(F.CACT + row * MW + mh * 256 + lane * 4) = pack4(t * misc[0] * cg); }
}

__device__ __forceinline__ void ret_out_unit(const Frame& F, int b, int h, int c) {
    LAS unsigned char* img = F.lds; const int w = F.wave, tid = launder(F.tid), lane = tid & 63, fr = lane & 15, fq = lane >> 4;
    LAS unsigned char* Pw = F.lds + 67584 + w * 4352;
    const size_t r0 = (size_t)b * 2048 + c * 128; const int i = 16 * w + fr; const float l2g = log2gamma(h);
    bf16x8 qf[8];
#pragma unroll
    for (int s = 0; s < 8; ++s) qf[s] = *(const bf16x8*)(F.Z + (r0 + i) * LDZ + ZC_Q + h * 256 + 32 * s + 8 * fq);
    f32x4 acc[16];
#pragma unroll
    for (int n = 0; n < 16; ++n) acc[n] = (f32x4){0.f, 0.f, 0.f, 0.f};
    __syncthreads();
    if (c > 0) {
        stage_tile256<256>(img, F.RS + ((size_t)(b * 8 + h) * 15 + (c - 1)) * 65536, 256, tid);
        __syncthreads();
#pragma unroll
        for (int n = 0; n < 16; ++n) {
#pragma unroll
            for (int s = 0; s < 8; ++s) acc[n] = mma(acc[n], *(const LAS bf16x8*)(img + (16 * n + fr) * IMG_PITCH + (32 * s + 8 * fq) * 2), qf[s]);
            __builtin_amdgcn_sched_barrier(0); }
        const float dq = ex2((float)(i + 1) * l2g);
#pragma unroll
        for (int n = 0; n < 16; ++n) acc[n] = acc[n] * dq;
        __syncthreads();
    }
    stage_tile256<128>(img, F.Z + r0 * LDZ + ZC_K + h * 256, LDZ, tid);
    __syncthreads();
#pragma unroll
    for (int n = 0; n < 8; ++n) {
        f32x4 sa = (f32x4){0.f, 0.f, 0.f, 0.f};
        if (n <= w) {
#pragma unroll
            for (int s = 0; s < 8; ++s) sa = mma(sa, *(const LAS bf16x8*)(img + (16 * n + fr) * IMG_PITCH + (32 * s + 8 * fq) * 2), qf[s]);
#pragma unroll
            for (int e = 0; e < 4; ++e) { const int dij = i - (16 * n + 4 * fq + e); sa[e] = dij >= 0 ? sa[e] * ex2((float)dij * l2g) : 0.f; }
        }
        *(LAS u32x2*)(Pw + fr * 272 + (16 * n + 4 * fq) * 2) = pack4(sa); __builtin_amdgcn_sched_barrier(0);
    }
    __syncthreads();
    stage_tile256<128>(img, F.Z + r0 * LDZ + ZC_RV + h * 256, LDZ, tid);
    __syncthreads();
    const int smax = w >> 1;
#pragma unroll
    for (int s = 0; s < 4; ++s) if (s <= smax) {
        const bf16x8 pf = *(const LAS bf16x8*)(Pw + fr * 272 + (32 * s + 8 * fq) * 2);
#pragma unroll
        for (int n = 0; n < 16; ++n) { acc[n] = mma(acc[n], tr_frag(img, IMG_PITCH, 32 * s, 16 * n, lane), pf); if ((n & 3) == 3) __builtin_amdgcn_sched_barrier(0); }
    }
    float sm = 0.f;
#pragma unroll
    for (int n = 0; n < 16; ++n) sm += hsum4(acc[n]);
    sm += __shfl_xor(sm, 16); sm += __shfl_xor(sm, 32); const float mean = sm * (1.0f / 256.0f);
    float sq = 0.f;
#pragma unroll
    for (int n = 0; n < 16; ++n) { acc[n] = acc[n] - mean; sq += dot4(acc[n], acc[n]); }
    sq += __shfl_xor(sq, 16); sq += __shfl_xor(sq, 32); const float rs = 1.0f / sqrtf(sq * (1.0f / 256.0f) + EPS);
    const bf16_t* zr = F.Z + (r0 + i) * LDZ + ZC_RG + h * 256; bf16_t* br = F.BACT + (r0 + i) * RW + h * 256;
#pragma unroll
    for (int n = 0; n < 16; ++n) { const int dv = 16 * n + 4 * fq; const f32x4 gr = *(const f32x4*)(F.g_ret + h * 256 + dv), rg = unpk4(*(const u32x2*)(zr + dv));
        *(u32x2*)(br + dv) = pack4(acc[n] * rs * gr * rg); }
}
__device__ __forceinline__ void xattn_unit(const Frame& F, int b, int mh, int qb) {
    LAS unsigned char* img = F.lds; const int w = F.wave, tid = launder(F.tid), lane = tid & 63, fr = lane & 15, fq = lane >> 4;
    LAS unsigned char* Pw = F.lds + w * 8448; LAS unsigned char* imgV = F.lds + 67584;
    const size_t r0 = (size_t)b * 2048 + qb * 128; const int i = 16 * w + fr;
    bf16x8 qf[8];
#pragma unroll
    for (int s = 0; s < 8; ++s) qf[s] = *(const bf16x8*)(F.Z + (r0 + i) * LDZ + ZC_CQ + mh * 256 + 32 * s + 8 * fq);
    __syncthreads();
    stage_tile256<256>(img, F.MKV + (size_t)(b * 256) * 2048 + mh * 256, 2048, tid);
    __syncthreads();
    f32x4 acc[16];
#pragma unroll
    for (int n = 0; n < 16; ++n) { acc[n] = (f32x4){0.f, 0.f, 0.f, 0.f};
#pragma unroll
        for (int s = 0; s < 8; ++s) acc[n] = mma(acc[n], *(const LAS bf16x8*)(img + (16 * n + fr) * IMG_PITCH + (32 * s + 8 * fq) * 2), qf[s]); __builtin_amdgcn_sched_barrier(0); }
    float mx = -3.0e38f;
#pragma unroll
    for (int n = 0; n < 16; ++n) mx = fmaxf(mx, fmaxf(fmaxf(acc[n][0], acc[n][1]), fmaxf(acc[n][2], acc[n][3])));
    mx = fmaxf(mx, __shfl_xor(mx, 16)); mx = fmaxf(mx, __shfl_xor(mx, 32));
    float sm = 0.f;
#pragma unroll
    for (int n = 0; n < 16; ++n) {
#pragma unroll
        for (int e = 0; e < 4; ++e) acc[n][e] = ex2((acc[n][e] - mx) * 1.4426950408889634f);
        sm += hsum4(acc[n]); }
    sm += __shfl_xor(sm, 16); sm += __shfl_xor(sm, 32); const float inv = 1.0f / sm;
    __syncthreads();
#pragma unroll
    for (int n = 0; n < 16; ++n) { *(LAS u32x2*)(Pw + fr * IMG_PITCH + (16 * n + 4 * fq) * 2) = pack4(acc[n]); acc[n] = (f32x4){0.f, 0.f, 0.f, 0.f}; }
#pragma unroll
    for (int hf = 0; hf < 2; ++hf) {
        stage_tile256<128>(imgV, F.MKV + (size_t)(b * 256 + hf * 128) * 2048 + 1024 + mh * 256, 2048, tid);
        __syncthreads();
#pragma unroll
        for (int s = 0; s < 4; ++s) { const bf16x8 pf = *(const LAS bf16x8*)(Pw + fr * IMG_PITCH + (hf * 128 + 32 * s + 8 * fq) * 2);
#pragma unroll
            for (int n = 0; n < 16; ++n) { acc[n] = mma(acc[n], tr_frag(imgV, IMG_PITCH, 32 * s, 16 * n, lane), pf); if ((n & 3) == 3) __builtin_amdgcn_sched_barrier(0); } }
        __syncthreads();
    }
    const bf16_t* zr = F.Z + (r0 + i) * LDZ + ZC_CG + mh * 256; bf16_t* cr = F.CACT + (r0 + i) * MW + mh * 256;
#pragma unroll
    for (int n = 0; n < 16; ++n) { const int dv = 16 * n + 4 * fq; *(u32x2*)(cr + dv) = pack4(acc[n] * inv * unpk4(*(const u32x2*)(zr + dv))); }
}

template <int K>
__device__ __forceinline__ f32x4 skinny_dot(const bf16_t* arow, const bf16_t* brow) {
    f32x4 a0 = (f32x4){0.f, 0.f, 0.f, 0.f}, a1 = a0, a2 = a0, a3 = a0;
#pragma unroll 2
    for (int s = 0; s < K / 32; s += 8) {
        bf16x8 fa[8], fb[8];
#pragma unroll
        for (int j = 0; j < 8; ++j) { fa[j] = *(const bf16x8*)(arow + 32 * (s + j)); fb[j] = *(const bf16x8*)(brow + 32 * (s + j)); }
        a0 = mma(a0, fb[0], fa[0]); a1 = mma(a1, fb[1], fa[1]); a2 = mma(a2, fb[2], fa[2]); a3 = mma(a3, fb[3], fa[3]);
        a0 = mma(a0, fb[4], fa[4]); a1 = mma(a1, fb[5], fa[5]); a2 = mma(a2, fb[6], fa[6]); a3 = mma(a3, fb[7], fa[7]);
    }
    return (a0 + a1) + (a2 + a3);
}

struct Args { const float* in[19]; float* out; unsigned char* ws; int ph_lo, ph_hi; };
__global__ void __launch_bounds__(512, 2) mega_fwd(Args args) {
    extern __shared__ __attribute__((aligned(16))) unsigned char lds[];
    Frame F;
    F.lds = (LAS unsigned char*)lds;
    volatile LAS unsigned* MISC = (volatile LAS unsigned*)(F.lds + MISC_OFF);
    F.tid = threadIdx.x; F.lane = F.tid & 63; F.wave = __builtin_amdgcn_readfirstlane(F.tid >> 6); F.G = gridDim.x; F.cu = blockIdx.x;
    F.xp = args.in[0]; F.xs = args.in[1]; F.state = args.in[2]; F.cmk = args.in[3]; F.cmv = args.in[4]; F.memp = args.in[5]; F.g_pre = args.in[6]; F.w_in = args.in[7]; F.g_anorm = args.in[8];
    F.w_s = args.in[9]; F.b_s = args.in[10]; F.g_ret = args.in[11]; F.g_mem = args.in[12]; F.w_mem = args.in[13]; F.w_oa = args.in[14]; F.w_ob = args.in[15]; F.w_oc = args.in[16]; F.w_out = args.in[17]; F.g_final = args.in[18];
    F.out = args.out; F.ws = args.ws; unsigned char* ws = args.ws;
    F.WinT = (bf16_t*)(ws + WS_WIN); F.WmemT = (bf16_t*)(ws + WS_WMEM); F.WoaT = (bf16_t*)(ws + WS_WOA); F.WobT = (bf16_t*)(ws + WS_WOB); F.WocT = (bf16_t*)(ws + WS_WOC); F.WoutT = (bf16_t*)(ws + WS_WOUT);
    F.H = (bf16_t*)(ws + WS_H); F.MEMN = (bf16_t*)(ws + WS_MEMN); F.Z = (bf16_t*)(ws + WS_Z); F.MKV = (bf16_t*)(ws + WS_MKV); F.RS = (bf16_t*)(ws + WS_RS);
    F.AACT = (bf16_t*)(ws + WS_AACT); F.BACT = (bf16_t*)(ws + WS_BACT); F.CACT = (bf16_t*)(ws + WS_CACT); F.MG = (bf16_t*)(ws + WS_MG);
    F.ropec = (float*)(ws + WS_ROPE); F.ropes = F.ropec + 2049 * 128; F.statv = (float*)(ws + WS_STATV); F.stato = (float*)(ws + WS_STATO); F.stats = (float*)(ws + WS_STATS); F.SH = (float*)(ws + WS_SH); F.SW = (float*)(ws + WS_SW); F.CMAX = (unsigned*)(ws + WS_CMAX); F.H8 = ws + WS_H8; F.W8 = ws + WS_W8;
    for (int u = F.tid; u < (LDS_BYTES - MISC_OFF) / 4; u += 512) ((LAS unsigned*)(F.lds + MISC_OFF))[u] = 0u;
    __syncthreads();
    XcdBarrier bar; bar.bar = (unsigned*)(ws + WS_CTL) + CW_BAR; bar.x = 0; bar.st = nullptr;
    if (MK_N_LAUNCHES == 1) bar = xcd_barrier_post((unsigned*)(ws + WS_CTL) + CW_BAR, MISC + 8);
    const int lo = args.ph_lo, hi = args.ph_hi;
#ifndef PHASE_MASK
#define PHASE_MASK 0xff
#endif
#define IN(k) (((PHASE_MASK >> (k)) & 1) && lo <= (k) && (k) < hi)
#define SEAM(k) do { if (IN(k) && IN((k) + 1)) xcd_barrier(bar); } while (0)
#ifndef REPEAT_PHASE
#define REPEAT_PHASE (-1)
#endif
#define REP(k) for (int rp_ = 0; rp_ < ((REPEAT_PHASE == (k)) ? 2 : 1); ++rp_, (void)((REPEAT_PHASE == (k) && rp_ == 1) ? (xcd_barrier(bar), 0) : 0))

    if (IN(0)) REP(0) { p0a_prologue(F); }
    SEAM(0);
    if (IN(1)) REP(1) {
        const int NGC = F.G >= 64 ? 32 : 0;
        if (NGC == 0 || F.cu < NGC) { pg8::Order S; S.init(F.MEMN, F.WmemT, 1024, 2048, NGC ? NGC : F.G, F.cu);
            EpiMem E{F.out + O_MK, F.out + O_MV, F.MKV};
            pg8::gemm_phase<EpiMem, pg8::Order, true>(F.lds, D, S, E); }
        if (NGC == 0 || F.cu >= NGC) { LAS float* scr = (LAS float*)(F.lds + F.wave * 8448);
            for (int it = (F.cu - NGC) * 8 + F.wave; it < 64 * 768; it += (F.G - NGC) * 8) p0_quant_item(F, scr, it, F.lane); }
    }
    SEAM(1);
    if (IN(2)) REP(2) {
        { pg8::OrderP1 S{F.H, F.WinT, F.G, F.cu, 0}; EpiZ<false> E{F.Z, F.statv, F.ropec, F.ropes, F.SH, F.SW};
          pg8::gemm_phase<EpiZ<false>, pg8::OrderP1, true, false>(F.lds, D, S, E); }
        { pg8::OrderP1 S{F.H8, F.W8, F.G, F.cu, 1}; EpiZ<true> E{F.Z, F.statv, F.ropec, F.ropes, F.SH, F.SW};
          pg8::gemm_phase<EpiZ<true>, pg8::OrderP1, true, true>(F.lds, D, S, E); }
    }
    SEAM(2);
    if (IN(3)) REP(3) {
        for (int u = F.cu; u < 256; u += F.G) scan_unit(F, u >> 6, (u >> 3) & 7, u & 7);
        for (int u = F.cu; u < 512; u += F.G) spatial_unit(F, u >> 7, (u >> 3) & 15, (u >> 1) & 3, u & 1);
        for (int s = F.cu * 8 + F.wave; s < MS; s += F.G * 8) spatial_sample_row(F, s);
        for (int u = F.cu; u < 1024; u += F.G) ret_sample_item(F, u >> 3, u & 7);
        for (int u = F.cu; u < 512; u += F.G) xattn_sample_item(F, u >> 2, u & 3);
#ifdef DIAG_ZERO_Y
        for (size_t i = (size_t)F.cu * 512 + F.tid; i < (O_RP / 4); i += (size_t)F.G * 512) ((f32x4*)F.out)[i] = (f32x4){0.f, 0.f, 0.f, 0.f};
#endif
    }
    SEAM(3);
    if (IN(4)) REP(4) {
        for (int u = F.cu; u < 512; u += F.G) ret_out_unit(F, u >> 7, (u >> 4) & 7, u & 15);
        for (int u = F.cu; u < 256; u += F.G) xattn_unit(F, u >> 6, (u >> 4) & 3, u & 15);
        __syncthreads();
    }
    SEAM(4);
    if (IN(5)) REP(5) {
        for (int pass = 0; pass < 3; ++pass) {
            const bf16_t* A = pass == 0 ? F.AACT : (pass == 1 ? F.BACT : F.CACT); const bf16_t* Bt = pass == 0 ? F.WoaT : (pass == 1 ? F.WobT : F.WocT); const int K = pass == 2 ? MW : AW;
            pg8::Order S; S.init(A, Bt, MP, D, F.G, F.cu);
            EpiMerge E{F.Z, F.MG, pass};
            pg8::gemm_phase<EpiMerge, pg8::Order>(F.lds, K, S, E);
        }
        { const int w = F.wave, fr = F.lane & 15, fq = F.lane >> 4; const size_t row = (size_t)MP + 16 * w + fr;
          for (int nt = F.cu; nt < 256; nt += F.G) { const int n0 = 16 * nt;
              const f32x4 ya = skinny_dot<AW>(F.AACT + row * AW + 8 * fq, F.WoaT + (size_t)(n0 + fr) * AW + 8 * fq);
              const f32x4 yb = skinny_dot<RW>(F.BACT + row * RW + 8 * fq, F.WobT + (size_t)(n0 + fr) * RW + 8 * fq);
              const f32x4 yc = skinny_dot<MW>(F.CACT + row * MW + 8 * fq, F.WocT + (size_t)(n0 + fr) * MW + 8 * fq);
              const bf16_t* gz = F.Z + row * LDZ + ZC_GS + n0 + 4 * fq;
              const f32x4 g0 = unpk4(*(const u32x2*)gz), g1 = unpk4(*(const u32x2*)(gz + D)), g2 = unpk4(*(const u32x2*)(gz + 2 * D));
              *(u32x2*)(F.MG + row * D + n0 + 4 * fq) = pack4(g0 * ya + g1 * yb + g2 * yc); } }
    }
    SEAM(5);
    if (IN(6)) REP(6) {
        { pg8::Order S; S.init(F.MG, F.WoutT, MP, D, F.G, F.cu);
          EpiOut E{F.xp, F.out + O_YP, F.stato};
          pg8::gemm_phase<EpiOut, pg8::Order>(F.lds, D, S, E); }
        { const int w = F.wave, fr = F.lane & 15, fq = F.lane >> 4; const int r = 16 * w + fr; const size_t row = (size_t)MP + r;
          for (int nt = F.cu; nt < 256; nt += F.G) { const int n0 = 16 * nt;
              const f32x4 y = skinny_dot<D>(F.MG + row * D + 8 * fq, F.WoutT + (size_t)(n0 + fr) * D + 8 * fq);
              const f32x4 v = *(const f32x4*)(F.xs + (size_t)r * D + n0 + 4 * fq) + y;
              *(f32x4*)(F.out + O_YS + (size_t)r * D + n0 + 4 * fq) = v;
              float q = dot4(v, v); q += __shfl_xor(q, 16); q += __shfl_xor(q, 32);
              if (fq == 0) F.stats[r * 256 + nt] = q; } }
    }
    SEAM(6);
    if (IN(7)) {
        const int lane = F.lane;
        for (int m = F.cu * 8 + F.wave; m < MREAL; m += F.G * 8) {
            float q; float* yr;
            if (m < MP) { q = wave_sum(F.stato[(size_t)m * 64 + lane]); yr = F.out + O_YP + (size_t)m * D; }
            else { const float* sp = F.stats + (size_t)(m - MP) * 256; q = wave_sum((sp[lane] + sp[lane + 64]) + (sp[lane + 128] + sp[lane + 192])); yr = F.out + O_YS + (size_t)(m - MP) * D; }
            const float r = 1.0f / sqrtf(q * (1.0f / 4096.0f) + EPS);
            f32x4* y4 = (f32x4*)yr + lane; const f32x4* g4 = (const f32x4*)F.g_final + lane;
            f32x4 v[16];
#pragma unroll
            for (int j = 0; j < 16; ++j) v[j] = y4[64 * j];
#pragma unroll
            for (int j = 0; j < 16; ++j) y4[64 * j] = v[j] * r * g4[64 * j];
        }
    }
#undef IN
#undef SEAM
}


__global__ void diag_hash(const unsigned char* ws, unsigned long long* table) {
    const unsigned* Z = (const unsigned*)(ws + WS_Z);
    const int segs[6] = {12288, 14336, 15360, 16384, 20480, 24576}; const int wid[6] = {2048, 1024, 1024, 4096, 4096, 4096};
    for (int r = 0; r < 6; ++r) { const int c0 = segs[r] / 2, nc = wid[r] / 2; unsigned long long h = 0;
        for (size_t i = (size_t)blockIdx.x * blockDim.x + threadIdx.x; i < (size_t)MPAD * nc; i += (size_t)gridDim.x * blockDim.x) { const size_t row = i / nc, c = i % nc; h += (unsigned long long)Z[row * (LDZ / 2) + c0 + c] * (unsigned long long)(i * 2654435761ull + 12345ull); }
        for (int o = 32; o >= 1; o >>= 1) h += __shfl_xor(h, o);
        if ((threadIdx.x & 63) == 0) atomicAdd(table + r, h); }
}
__global__ void diag_finish(float* out, const unsigned long long* t0, const unsigned long long* t1) {
    int mask = 0; for (int r = 0; r < 6; ++r) if (t0[r] != t1[r]) mask |= 1 << r;
    for (size_t i = (size_t)blockIdx.x * blockDim.x + threadIdx.x; i < O_END; i += (size_t)gridDim.x * blockDim.x) out[i] = (i == 0) ? __uint_as_float((unsigned)(127 + 10 + mask) << 23) : 0.f;
}
extern "C" void kernel_launch(void* const* d_in, const int* in_sizes, int n_in, void* d_out, int out_size, void* d_ws, size_t ws_size, hipStream_t stream) {
    static int grid = 0;
    if (grid == 0) {
        if (n_in != 19 || out_size != (int)O_END || ws_size < WS_END) { fprintf(stderr, "kernel_launch: unexpected problem shape (n_in %d, out %d, ws %zu); nothing launched\n", n_in, out_size, ws_size); grid = -1; return; }
        int dev = 0, cus = 0, per_cu = 0;
        if (hipGetDevice(&dev) != hipSuccess || hipDeviceGetAttribute(&cus, hipDeviceAttributeMultiprocessorCount, dev) != hipSuccess) { grid = -1; return; }
        if (hipFuncSetAttribute((const void*)mega_fwd, hipFuncAttributeMaxDynamicSharedMemorySize, LDS_BYTES) != hipSuccess) { fprintf(stderr, "kernel_launch: hipFuncSetAttribute failed\n"); grid = -1; return; }
        if (hipOccupancyMaxActiveBlocksPerMultiprocessor(&per_cu, (const void*)mega_fwd, 512, LDS_BYTES) != hipSuccess || per_cu < 1) fprintf(stderr, "kernel_launch: occupancy query says %d blocks per CU\n", per_cu);
        (void)hipGetLastError();
        grid = cus;
    }
    if (grid < 0) return;
    (void)hipMemsetAsync((char*)d_ws + WS_CTL, 0, CTL_ZERO_BYTES, stream);
    Args a{};
    for (int i = 0; i < 19; ++i) a.in[i] = (const float*)d_in[i];
    a.out = (float*)d_out; a.ws = (unsigned char*)d_ws;
#ifdef DIAG_DET
    for (int rep = 0; rep < 2; ++rep) { a.ph_lo = 0; a.ph_hi = 2; if (rep) (void)hipMemsetAsync((char*)d_ws + WS_CTL, 0, 32 * 1024, stream);
        hipLaunchKernelGGL(mega_fwd, dim3(grid), dim3(512), LDS_BYTES, stream, a);
        hipLaunchKernelGGL(diag_hash, dim3(1024), dim3(256), 0, stream, (const unsigned char*)d_ws, (unsigned long long*)((char*)d_ws + 32 * 1024 + rep * 1024)); }
    hipLaunchKernelGGL(diag_finish, dim3(1024), dim3(256), 0, stream, (float*)d_out, (const unsigned long long*)((char*)d_ws + 32 * 1024), (const unsigned long long*)((char*)d_ws + 33 * 1024));
    return;
#endif
    if (MK_N_LAUNCHES == 1) { a.ph_lo = 0; a.ph_hi = 8; hipLaunchKernelGGL(mega_fwd, dim3(grid), dim3(512), LDS_BYTES, stream, a); }
    else { for (int p = 0; p < 8; ++p) { a.ph_lo = p; a.ph_hi = p + 1; hipLaunchKernelGGL(mega_fwd, dim3(grid), dim3(512), LDS_BYTES, stream, a); } }
}
```

```cpp
#include <hip/hip_runtime.h>
#include <cstdio>
#include <cstdint>

#ifndef MK_N_LAUNCHES
#define MK_N_LAUNCHES 1
#endif

#define LAS __attribute__((address_space(3)))
#define GAS __attribute__((address_space(1)))
typedef unsigned short bf16_t;
typedef short bf16x8 __attribute__((ext_vector_type(8)));
typedef short s16x4 __attribute__((ext_vector_type(4)));
typedef float f32x4 __attribute__((ext_vector_type(4)));
typedef float f32x2 __attribute__((ext_vector_type(2)));
typedef unsigned u32x4 __attribute__((ext_vector_type(4)));
typedef unsigned u32x2 __attribute__((ext_vector_type(2)));
typedef int i32x4 __attribute__((ext_vector_type(4)));
typedef GAS unsigned gu32;

constexpr int D = 4096, MP = 8192, MS = 128, MREAL = MP + MS, MPAD = 8448;
constexpr int NIN = 28672, LDZ = NIN, AW = 2048, RW = 2048, MW = 1024;
constexpr int ZC_U = 0, ZC_V = 2048, ZC_G = 4096, ZC_Q = 6144, ZC_K = 8192, ZC_RV = 10240, ZC_RG = 12288, ZC_CQ = 14336, ZC_CG = 15360, ZC_GS = 16384;
constexpr float EPS = 1e-6f;
constexpr size_t O_YP = 0, O_YS = 33554432, O_RP = 34078720, O_MK = 36175872, O_MV = 37224448, O_RS = 38273024, O_GV = 105381888, O_END = 105644032;

constexpr size_t MiB = 1u << 20;
constexpr size_t WS_CTL = 0, CTL_ZERO_BYTES = 256 * 1024;
constexpr size_t WS_CMAX = 128 * 1024;
constexpr size_t WS_ROPE = 1 * MiB;
constexpr size_t WS_STATV = 4 * MiB;
constexpr size_t WS_STATO = 7 * MiB;
constexpr size_t WS_STATS = 10 * MiB;
constexpr size_t WS_WIN = 16 * MiB;
constexpr size_t WS_WMEM = 240 * MiB;
constexpr size_t WS_WOA = 256 * MiB;
constexpr size_t WS_WOB = 272 * MiB;
constexpr size_t WS_WOC = 288 * MiB;
constexpr size_t WS_WOUT = 296 * MiB;
constexpr size_t WS_H = 328 * MiB;
constexpr size_t WS_MEMN = 394 * MiB;
constexpr size_t WS_Z = 402 * MiB;
constexpr size_t WS_MKV = 864 * MiB;
constexpr size_t WS_RS = 868 * MiB;
constexpr size_t WS_AACT = 928 * MiB;
constexpr size_t WS_BACT = 961 * MiB;
constexpr size_t WS_CACT = 994 * MiB;
constexpr size_t WS_MG = 1012 * MiB;
constexpr size_t WS_H8 = 1100 * MiB;
constexpr size_t WS_W8 = 1136 * MiB;
constexpr size_t WS_SH = 12 * MiB;
constexpr size_t WS_SW = 13 * MiB;
constexpr size_t WS_A8 = 1232 * MiB, WS_B8 = 1248 * MiB, WS_C8 = 1264 * MiB, WS_M8 = 1272 * MiB;
constexpr size_t WS_W8A = 1304 * MiB, WS_W8B = 1312 * MiB, WS_W8C = 1320 * MiB, WS_W8O = 1324 * MiB;
constexpr size_t WS_SX = 14 * MiB;
constexpr size_t WS_END = 1340 * MiB;
static_assert(WS_WIN + (size_t)NIN * D * 2 <= WS_WMEM && WS_H + (size_t)MPAD * D * 2 <= WS_MEMN && WS_Z + (size_t)MPAD * LDZ * 2 <= WS_MKV, "ws map");
static_assert(WS_RS + (size_t)480 * 65536 * 2 <= WS_AACT && WS_AACT + (size_t)MPAD * AW * 2 <= WS_BACT && WS_CACT + (size_t)MPAD * MW * 2 <= WS_MG && WS_MG + (size_t)MPAD * D * 2 <= WS_END, "ws map 2");
constexpr int CW_BAR = 1024;

constexpr int RING_BYTES = 131072;
constexpr int IMG_PITCH = 528;
constexpr int SMALL_OFF = 135168;
constexpr int MISC_OFF = 151552;
constexpr int LDS_BYTES = 155648;

#define LDS_WAIT() asm volatile("s_waitcnt lgkmcnt(0)" ::: "memory")
#define VM_WAIT() asm volatile("s_waitcnt vmcnt(0)" ::: "memory")

namespace pg8 {
constexpr int BM = 256, BK = 64, HALF = 128, HTB = HALF * BK * 2, STAGE_BYTES = 8 * HTB, NXCD = 8, WGM = 8;
__host__ __device__ __forceinline__ int lds_byte(int r, int c) { const int st = (r >> 4) * 2 + (c >> 5), rr = r & 15, cc = c & 31, ob = rr * 64 + cc * 2; return st * 1024 + (ob ^ (((ob >> 9) & 1) << 5)); }
__host__ __device__ __forceinline__ void stage_rc(int b, int& R, int& C) { const int st = b / 1024, sb = b % 1024, swz = sb ^ (((sb >> 9) & 1) << 5); R = (st >> 1) * 16 + swz / 64; C = (st & 1) * 32 + (swz % 64) / 2; }
__host__ __device__ __forceinline__ int perm32(int rho) { const int n = rho >> 4, i = rho & 15; return 8 * (i >> 2) + 4 * n + (i & 3); }

struct Unit { int pm, pn, kind; };

struct Order {
    const bf16_t *A0, *B0, *A1, *B1; int nM, nN, nwg, nX, nXn, G, c;
    __device__ __forceinline__ void init(const bf16_t* a0, const bf16_t* b0, int M, int N, int G_, int c_) { A0 = a0; B0 = b0; A1 = a0; B1 = b0; nM = M / BM; nN = N / BM; nwg = nM * nN; nX = 0; nXn = 1; G = G_; c = c_; }
    __device__ __forceinline__ bool next(int i, Unit& u) const {
        const long L = (long)i * G + c; const bool ok = L < nwg + nX; const bool ex = L >= nwg;
        const int r = (int)L - nwg;
        int wgid = ex ? 0 : (int)L; { const int q = nwg / NXCD, rr = nwg % NXCD, xcd = wgid % NXCD, off = wgid / NXCD; wgid = (xcd < rr ? xcd * (q + 1) : rr * (q + 1) + (xcd - rr) * q) + off; }
        const int nig = WGM * nN, gid = wgid / nig, fm = gid * WGM, gsz = (nM - fm) < WGM ? (nM - fm) : WGM;
        const int pm0 = fm + ((wgid % nig) % gsz), pn0 = (wgid % nig) / gsz;
        const int pm = ex ? r / nXn : pm0, pn = ex ? r % nXn : pn0;
        u.pm = pm; u.pn = pn; u.kind = ex ? 1 : 0; return ok;
    }
    __device__ __forceinline__ void operands(const Unit& u, size_t tstep, const char*& a, const char*& b) const {
        a = (const char*)(u.kind ? A1 : A0) + (size_t)u.pm * tstep; b = (const char*)(u.kind ? B1 : B0) + (size_t)u.pn * tstep; }
};

struct OrderP1 {
    const void* A; const void* B; int G, c, i8;
    __device__ __forceinline__ bool next(int i, Unit& u) const {
        if (!i8) { const long L = (long)i * G + c; const bool ok = L < 536; const bool smp = L >= 512; const int t = (int)L - 512;
            int wgid = smp ? 0 : (int)L; wgid = (wgid % 8) * 64 + wgid / 8;
            const int pm0 = (wgid / 128) * 8 + ((wgid % 128) % 8), pn0 = 32 + (wgid % 128) / 8;
            u.pm = smp ? 32 : pm0; u.pn = smp ? (t < 8 ? 8 + t : 24 + t) : pn0; u.kind = 0; return ok; }
        long j = (long)i * G + c;
        if (G == 256) { j = 1 << 30; if (i < 11) j = c + 256 * i; else if (i == 11 && c >= 24) j = 2816 + (c - 24); else if (i == 12 && c >= 24 && c < 144) j = 3048 + (c - 24); }
        const bool ok = j < 3168;
        int wgid = ok ? (int)j : 0; wgid = (wgid % 8) * 396 + wgid / 8;
        const int gid = wgid / 768, fm = gid * 8, gsz = (33 - fm) < 8 ? (33 - fm) : 8;
        u.pm = fm + ((wgid % 768) % gsz); u.pn = (wgid % 768) / gsz; u.kind = 0; return ok;
    }
    __device__ __forceinline__ void operands(const Unit& u, size_t tstep, const char*& a, const char*& b) const { a = (const char*)A + (size_t)u.pm * tstep; b = (const char*)B + (size_t)u.pn * tstep; }
};

typedef float cvf32x2_t __attribute__((ext_vector_type(2))); typedef __bf16 cvbf16x2_t __attribute__((ext_vector_type(2)));
__device__ __forceinline__ unsigned cvt_pk_bf16(float lo, float hi) { cvf32x2_t v = {lo, hi}; cvbf16x2_t b = __builtin_convertvector(v, cvbf16x2_t); return __builtin_bit_cast(unsigned, b); }

template <class Epi, class Sched, bool IMG = false, bool I8 = false, bool ALIGN_EPI = true, bool SP2 = true>
__device__ __forceinline__ void gemm_phase(LAS unsigned char* lds, const int K, const Sched& S, const Epi& E) {
    const int tid = threadIdx.x, wid = __builtin_amdgcn_readfirstlane(tid >> 6), lane = tid & 63, wr = wid >> 2, wc = wid & 3, fr = lane & 15, fq = lane >> 4;
    const int nt = I8 ? K / 128 : K / BK;
    unsigned voffA[2], voffB[2];
#pragma unroll
    for (int i = 0; i < 2; ++i) { int R, C; stage_rc(tid * 16 + i * 8192, R, C); const int Rb = Epi::PERM ? ((R & ~31) + perm32(R & 31)) : R;
        voffA[i] = (unsigned)(R * K + C) * 2u; voffB[i] = (unsigned)(Rb * K + C) * 2u;
        if (IMG) { voffA[i] = (unsigned)(tid * 16 + i * 8192); voffB[i] = voffA[i]; } }
    const size_t kstep = IMG ? (size_t)HTB : (size_t)(BK * 2);
    const size_t hstep = (size_t)HALF * K * (I8 ? 1 : 2);
    const size_t tstep = 2 * hstep;
    const unsigned ldsw = (unsigned)wid * 1024u;
    const int aoff = lds_byte(wr * 64 + fr, fq * 8), boff = lds_byte(wc * 32 + fr, fq * 8);
#define PG8_SA(b, h) (((b) * 2 + (h)) * HTB)
#define PG8_SB(b, h) ((4 + (b) * 2 + (h)) * HTB)
#define PG8_STAGE(bufoff, gbase, voff) do { _Pragma("unroll") for (int _i = 0; _i < 2; ++_i) \
        __builtin_amdgcn_global_load_lds((const unsigned*)((const char*)(gbase) + (voff)[_i]), (LAS unsigned*)(lds + (bufoff) + ldsw + _i * 8192), 16, 0, 0); } while (0)
#define PG8_LDA(dst, b, h) do { _Pragma("unroll") for (int m = 0; m < 4; ++m) _Pragma("unroll") for (int k = 0; k < 2; ++k) dst[m][k] = *(const LAS bf16x8*)(lds + PG8_SA(b, h) + aoff + m * 2048 + k * 1024); } while (0)
#define PG8_LDB(dst, b, h) do { _Pragma("unroll") for (int n = 0; n < 2; ++n) _Pragma("unroll") for (int k = 0; k < 2; ++k) dst[n][k] = *(const LAS bf16x8*)(lds + PG8_SB(b, h) + boff + n * 2048 + k * 1024); } while (0)
#define PG8_MMA(ai, bj, At, Bt) do { __builtin_amdgcn_s_setprio(1); _Pragma("unroll") for (int m = 0; m < 4; ++m) _Pragma("unroll") for (int n = 0; n < 2; ++n) _Pragma("unroll") for (int k = 0; k < 2; ++k) \
        { if constexpr (I8) acc[ai][bj][m][n] = __builtin_bit_cast(f32x4, __builtin_amdgcn_mfma_i32_16x16x64_i8(__builtin_bit_cast(i32x4, Bt[n][k]), __builtin_bit_cast(i32x4, At[m][k]), __builtin_bit_cast(i32x4, acc[ai][bj][m][n]), 0, 0, 0)); \
          else acc[ai][bj][m][n] = __builtin_amdgcn_mfma_f32_16x16x32_bf16(Bt[n][k], At[m][k], acc[ai][bj][m][n], 0, 0, 0); } __builtin_amdgcn_s_setprio(0); } while (0)
#define PG8_WAIT_V(n) asm volatile("s_waitcnt vmcnt(" #n ")" ::: "memory")
#define PG8_WAIT_L(n) asm volatile("s_waitcnt lgkmcnt(" #n ")" ::: "memory")
#define PG8_BAR __builtin_amdgcn_s_barrier()
#define PG8_SCHED __builtin_amdgcn_sched_barrier(0)
    Unit cur, nxt; int ui = 0;
    if (!S.next(0, cur)) return;
    f32x4 acc[2][2][4][2];
#pragma unroll
    for (int a = 0; a < 2; ++a)
#pragma unroll
        for (int b = 0; b < 2; ++b)
#pragma unroll
            for (int m = 0; m < 4; ++m)
#pragma unroll
                for (int n = 0; n < 2; ++n) acc[a][b][m][n] = (f32x4){0.f, 0.f, 0.f, 0.f};
    bf16x8 At[4][2], B0[2][2], B1[2][2];
    const char* cA; const char* cB; S.operands(cur, tstep, cA, cB);
    if constexpr (SP2) {
        PG8_STAGE(PG8_SB(0, 0), cB, voffB); PG8_STAGE(PG8_SB(0, 1), cB + hstep, voffB); PG8_STAGE(PG8_SA(0, 0), cA, voffA); PG8_STAGE(PG8_SA(0, 1), cA + hstep, voffA);
        if (wr == 1) PG8_BAR;
        PG8_WAIT_V(2); PG8_BAR;
        PG8_STAGE(PG8_SB(1, 0), cB + kstep, voffB); PG8_STAGE(PG8_SA(1, 0), cA + kstep, voffA); PG8_STAGE(PG8_SB(1, 1), cB + hstep + kstep, voffB);
        PG8_WAIT_V(6); PG8_BAR;
    } else {
        PG8_STAGE(PG8_SB(0, 0), cB, voffB); PG8_STAGE(PG8_SA(0, 0), cA, voffA); PG8_STAGE(PG8_SB(0, 1), cB + hstep, voffB); PG8_STAGE(PG8_SA(0, 1), cA + hstep, voffA);
        if (wr == 1) PG8_BAR;
        PG8_WAIT_V(4); PG8_BAR;
        PG8_STAGE(PG8_SB(1, 0), cB + kstep, voffB); PG8_STAGE(PG8_SA(1, 0), cA + kstep, voffA); PG8_STAGE(PG8_SB(1, 1), cB + hstep + kstep, voffB);
        PG8_WAIT_V(6); PG8_BAR;
    }
    for (;;) {
        const bool has_next = S.next(ui + 1, nxt);
        const char* nA = cA; const char* nB = cB; if (has_next) S.operands(nxt, tstep, nA, nB);
        for (int t = 0; t < nt; t += 2) {
            const bool last = (t == nt - 2);
            const char* a1 = cA + (size_t)(t + 1) * kstep;
            const char* a2 = last ? nA : cA + (size_t)(t + 2) * kstep; const char* b2 = last ? nB : cB + (size_t)(t + 2) * kstep;
            const char* a3 = a2 + kstep; const char* b3 = b2 + kstep;
            if constexpr (SP2) {
            PG8_LDB(B0, 0, 0); PG8_LDB(B1, 0, 1); PG8_SCHED; PG8_LDA(At, 0, 0); PG8_STAGE(PG8_SA(1, 1), a1 + hstep, voffA);
            PG8_WAIT_V(8); PG8_WAIT_L(0); PG8_BAR; PG8_MMA(0, 0, At, B0); PG8_MMA(0, 1, At, B1); PG8_BAR; PG8_SCHED;
            PG8_LDA(At, 0, 1); PG8_STAGE(PG8_SB(0, 0), b2, voffB); PG8_STAGE(PG8_SB(0, 1), b2 + hstep, voffB); PG8_STAGE(PG8_SA(0, 0), a2, voffA);
            PG8_WAIT_V(8); PG8_WAIT_L(0); PG8_BAR; PG8_MMA(1, 0, At, B0); PG8_MMA(1, 1, At, B1); PG8_BAR; PG8_SCHED;
            PG8_LDB(B0, 1, 0); PG8_LDB(B1, 1, 1); PG8_SCHED; PG8_LDA(At, 1, 0); PG8_STAGE(PG8_SA(0, 1), a2 + hstep, voffA);
            PG8_WAIT_V(8); PG8_WAIT_L(0); PG8_BAR; PG8_MMA(0, 0, At, B0); PG8_MMA(0, 1, At, B1); PG8_BAR; PG8_SCHED;
            PG8_LDA(At, 1, 1); PG8_STAGE(PG8_SB(1, 0), b3, voffB); PG8_STAGE(PG8_SB(1, 1), b3 + hstep, voffB); PG8_STAGE(PG8_SA(1, 0), a3, voffA);
            PG8_WAIT_V(8); PG8_WAIT_L(0); PG8_BAR; PG8_MMA(1, 0, At, B0); PG8_MMA(1, 1, At, B1); PG8_BAR; PG8_SCHED;
            } else {
            PG8_LDB(B0, 0, 0); PG8_SCHED; PG8_LDA(At, 0, 0); PG8_STAGE(PG8_SA(1, 1), a1 + hstep, voffA);
            PG8_WAIT_L(8); PG8_BAR; PG8_WAIT_L(0); PG8_MMA(0, 0, At, B0); PG8_BAR; PG8_SCHED;
            PG8_LDB(B1, 0, 1); PG8_STAGE(PG8_SB(0, 0), b2, voffB);
            PG8_BAR; PG8_WAIT_L(0); PG8_MMA(0, 1, At, B1); PG8_BAR;
            PG8_LDA(At, 0, 1); PG8_STAGE(PG8_SA(0, 0), a2, voffA);
            PG8_BAR; PG8_WAIT_L(0); PG8_MMA(1, 0, At, B0); PG8_BAR; PG8_SCHED;
            PG8_STAGE(PG8_SB(0, 1), b2 + hstep, voffB);
            PG8_WAIT_V(6); PG8_BAR; PG8_MMA(1, 1, At, B1); PG8_BAR;
            PG8_LDB(B0, 1, 0); PG8_SCHED; PG8_LDA(At, 1, 0); PG8_STAGE(PG8_SA(0, 1), a2 + hstep, voffA);
            PG8_WAIT_L(8); PG8_BAR; PG8_WAIT_L(0); PG8_MMA(0, 0, At, B0); PG8_BAR; PG8_SCHED;
            PG8_LDB(B1, 1, 1); PG8_STAGE(PG8_SB(1, 0), b3, voffB);
            PG8_BAR; PG8_WAIT_L(0); PG8_MMA(0, 1, At, B1); PG8_BAR;
            PG8_LDA(At, 1, 1); PG8_STAGE(PG8_SA(1, 0), a3, voffA);
            PG8_BAR; PG8_WAIT_L(0); PG8_MMA(1, 0, At, B0); PG8_BAR; PG8_SCHED;
            PG8_STAGE(PG8_SB(1, 1), b3 + hstep, voffB);
            PG8_WAIT_V(6); PG8_BAR; PG8_MMA(1, 1, At, B1); PG8_BAR;
            }
        }
        if constexpr (ALIGN_EPI) { if (wr == 0) PG8_BAR; }
        E(acc, cur, wr, wc, fr, fq);
        if (!has_next) break;
#pragma unroll
        for (int a = 0; a < 2; ++a)
#pragma unroll
            for (int b = 0; b < 2; ++b)
#pragma unroll
                for (int m = 0; m < 4; ++m)
#pragma unroll
                    for (int n = 0; n < 2; ++n) acc[a][b][m][n] = (f32x4){0.f, 0.f, 0.f, 0.f};
        cur = nxt; cA = nA; cB = nB; ++ui;
        if constexpr (ALIGN_EPI) { if (wr == 1) PG8_BAR; }
    }
    PG8_WAIT_V(0);
    if constexpr (!ALIGN_EPI) { if (wr == 0) PG8_BAR; }
    PG8_BAR;
#undef PG8_SA
#undef PG8_SB
#undef PG8_STAGE
#undef PG8_LDA
#undef PG8_LDB
#undef PG8_MMA
#undef PG8_WAIT_V
#undef PG8_WAIT_L
#undef PG8_BAR
#undef PG8_SCHED
}
}


__device__ __forceinline__ size_t img_off(int row, int k, int K) { return ((size_t)(row >> 7) * (size_t)(K >> 6) + (size_t)(k >> 6)) * 16384u + (size_t)pg8::lds_byte(row & 127, k & 63); }
__device__ __forceinline__ size_t img8_off(int row, int k, int K) { return ((size_t)(row >> 7) * (size_t)(K >> 7) + (size_t)(k >> 7)) * 16384u + (size_t)pg8::lds_byte(row & 127, (k & 127) >> 1) + (size_t)(k & 1); }
__device__ __forceinline__ int perm_slot(int n) { const int s = n & 31; return (n & ~31) + 16 * ((s >> 2) & 1) + 4 * (s >> 3) + (s & 3); }
__device__ __forceinline__ unsigned pk2(float lo, float hi) { return pg8::cvt_pk_bf16(lo, hi); }
__device__ __forceinline__ float bflo(unsigned u) { return __uint_as_float(u << 16); }
__device__ __forceinline__ float bfhi(unsigned u) { return __uint_as_float(u & 0xffff0000u); }
__device__ __forceinline__ float bf1(bf16_t b) { return __uint_as_float(((unsigned)b) << 16); }
__device__ __forceinline__ f32x4 unpk4(u32x2 w) { return (f32x4){bflo(w.x), bfhi(w.x), bflo(w.y), bfhi(w.y)}; }
__device__ __forceinline__ u32x2 pack4(f32x4 v) { u32x2 w; w.x = pk2(v[0], v[1]); w.y = pk2(v[2], v[3]); return w; }
__device__ __forceinline__ float wave_sum(float v) {
#pragma unroll
    for (int o = 1; o < 64; o <<= 1) v += __shfl_xor(v, o);
    return v;
}
__device__ __forceinline__ float wave_max(float v) {
#pragma unroll
    for (int o = 1; o < 64; o <<= 1) v = fmaxf(v, __shfl_xor(v, o));
    return v;
}
__device__ __forceinline__ float ex2(float x) { return __builtin_amdgcn_exp2f(x); }
__device__ __forceinline__ float rcp(float x) { return __builtin_amdgcn_rcpf(x); }
__device__ __forceinline__ float sigm(float x) { return rcp(1.0f + ex2(-1.4426950408889634f * x)); }
__device__ __forceinline__ float silu(float x) { return x * sigm(x); }
__device__ __forceinline__ float gelu_t(float x) { const float u = x * (1.0f + 0.044715f * x * x); return x * rcp(1.0f + ex2(-2.3022081982f * u)); }
__device__ __forceinline__ float dot4(f32x4 a, f32x4 b) { return (a[0] * b[0] + a[1] * b[1]) + (a[2] * b[2] + a[3] * b[3]); }
__device__ __forceinline__ float hsum4(f32x4 a) { return (a[0] + a[1]) + (a[2] + a[3]); }
__device__ __forceinline__ float log2gamma(int h) { return log2f(1.0f - exp2f(-5.0f - (float)h)); }

__device__ __forceinline__ int launder(int v) { asm volatile("" : "+v"(v)); return v; }
__device__ __forceinline__ bf16x8 tr_frag(LAS const unsigned char* img, int pitch, int k0, int c0, int lane) {
    const int g = lane >> 4, q = (lane & 15) >> 2, p = lane & 3;
    LAS const unsigned char* a = img + (k0 + 8 * g + q) * pitch + (c0 + 4 * p) * 2;
    const s16x4 lo = __builtin_amdgcn_ds_read_tr16_b64_v4i16((LAS s16x4*)a);
    const s16x4 hi = __builtin_amdgcn_ds_read_tr16_b64_v4i16((LAS s16x4*)(a + 4 * pitch));
    return (bf16x8){lo[0], lo[1], lo[2], lo[3], hi[0], hi[1], hi[2], hi[3]};
}
__device__ __forceinline__ f32x4 mma(f32x4 acc, bf16x8 fcols, bf16x8 frows) { return __builtin_amdgcn_mfma_f32_16x16x32_bf16(fcols, frows, acc, 0, 0, 0); }

#define XB_TMO      128
#define XB_XCNT(j)  (256  + 64 * (j))
#define XB_XSUB(j)  (1280 + 64 * (j))
#define XB_XGEN(j)  (2304 + 64 * (j))
#define XB_TOP      3328
#define XB_TOPGEN   3392
#define XCD_BAR_WORDS 3456
#define XB_SPIN_CAP (1u << 22)
__device__ __forceinline__ unsigned xb_ld(unsigned* p)              { return __hip_atomic_load(p, __ATOMIC_RELAXED, __HIP_MEMORY_SCOPE_AGENT); }
__device__ __forceinline__ unsigned xb_add(unsigned* p, unsigned v) { return __hip_atomic_fetch_add(p, v, __ATOMIC_RELAXED, __HIP_MEMORY_SCOPE_AGENT); }
__device__ __forceinline__ unsigned xb_xcc_id() { return (unsigned)__builtin_amdgcn_s_getreg((3 << 11) | 20) & 0xFu; }
#define XB_SPIN(cond, bar) do { unsigned _sp = 0; while (cond) { __builtin_amdgcn_s_sleep(1); \
    if ((++_sp & 255u) == 0u) { if (xb_ld(&(bar)[XB_TMO])) break; if (_sp > XB_SPIN_CAP) { atomicAdd(&(bar)[XB_TMO], 1u); break; } } } } while (0)
struct XcdBarrier { unsigned* bar; unsigned x; volatile LAS unsigned* st; };
__device__ __forceinline__ XcdBarrier xcd_barrier_post(unsigned* bar, volatile LAS unsigned* st) {
    XcdBarrier b; b.bar = bar; b.x = xb_xcc_id(); b.st = st;
    if (threadIdx.x == 0) (void)xb_add(&bar[XB_XCNT(b.x)], 1u);
    return b;
}
__device__ __forceinline__ void xcd_barrier_complete(unsigned* bar, unsigned x, unsigned& nloc, unsigned& nx) {
    const unsigned G = gridDim.x * gridDim.y * gridDim.z;
    unsigned sum, cnt, mine, sp = 0u;
    for (;;) {
        sum = 0u; cnt = 0u; mine = 0u;
#pragma unroll
        for (unsigned j = 0; j < 16; ++j) { const unsigned c = xb_ld(&bar[XB_XCNT(j)]); sum += c; cnt += (c > 0u) ? 1u : 0u; mine = (j == x) ? c : mine; }
        if (sum == G) break;
        __builtin_amdgcn_s_sleep(1);
        if ((++sp & 255u) == 0u) { if (xb_ld(&bar[XB_TMO])) break; if (sp > XB_SPIN_CAP) { atomicAdd(&bar[XB_TMO], 1u); break; } }
    }
    nloc = mine > 0u ? mine : 1u; nx = cnt > 0u ? cnt : 1u;
}
__device__ __forceinline__ void xcd_barrier(const XcdBarrier& b) {
    asm volatile("s_waitcnt vmcnt(0)" ::: "memory");
    __syncthreads();
    if (threadIdx.x == 0) {
        unsigned* bar = b.bar;
        __builtin_amdgcn_s_waitcnt(0);
        unsigned nloc = b.st[0], nx = b.st[1];
        if (nloc == 0u) { xcd_barrier_complete(bar, b.x, nloc, nx); b.st[0] = nloc; b.st[1] = nx; }
        const unsigned old = xb_add(&bar[XB_XSUB(b.x)], 1u);
        const unsigned gen = old / nloc;
        if (old + 1u == (gen + 1u) * nloc) {
            __builtin_amdgcn_fence(__ATOMIC_RELEASE, "agent");
            asm volatile("s_waitcnt vmcnt(0)" ::: "memory");
            const unsigned og = xb_add(&bar[XB_TOP], 1u);
            const unsigned tg = og / nx;
            if (og + 1u == (tg + 1u) * nx) xb_add(&bar[XB_TOPGEN], 1u);
            else XB_SPIN(xb_ld(&bar[XB_TOPGEN]) == tg, bar);
            __builtin_amdgcn_fence(__ATOMIC_ACQUIRE, "agent");
            xb_add(&bar[XB_XGEN(b.x)], 1u);
            asm volatile("s_waitcnt vmcnt(0)" ::: "memory");
        } else {
            XB_SPIN(xb_ld(&bar[XB_XGEN(b.x)]) == gen, bar);
            __builtin_amdgcn_fence(__ATOMIC_ACQUIRE, "agent");
            asm volatile("s_waitcnt vmcnt(0)" ::: "memory");
        }
    }
    __syncthreads();
}

struct Frame {
    LAS unsigned char* lds;
    int tid, lane, wave, G, cu;
    const float *xp, *xs, *state, *cmk, *cmv, *memp, *g_pre, *w_in, *g_anorm, *w_s, *b_s, *g_ret, *g_mem, *w_mem, *w_oa, *w_ob, *w_oc, *w_out, *g_final;
    float* out; unsigned char* ws;
    bf16_t *WinT, *WmemT, *WoaT, *WobT, *WocT, *WoutT, *H, *MEMN, *Z, *MKV, *RS, *AACT, *BACT, *CACT, *MG;
    float *ropec, *ropes, *statv, *stato, *stats, *SH, *SW, *sA, *sB, *sC, *sM, *SWa, *SWb, *SWc, *SWo; unsigned* CMAX; unsigned char *H8, *W8, *A8, *B8, *C8, *M8, *W8a, *W8b, *W8c, *W8o;
};

template <bool I8> struct EpiZ {
    static constexpr bool PERM = true;
    bf16_t* Z; float* statv; const float* ropec; const float* ropes; const float* sh; const float* sw;
    template <int ACT> __device__ __forceinline__ void ew(const f32x4 (&acc)[2][2][4][2], int pn, int row0, int wc, int fq) const {
        bf16_t* zb = Z + (size_t)pn * 256 + wc * 32 + 8 * fq;
#pragma unroll
        for (int ai = 0; ai < 2; ++ai)
#pragma unroll
            for (int m = 0; m < 4; ++m) { const size_t row = (size_t)(row0 + ai * 128 + m * 16); float s = 0.f, q = 0.f;
#pragma unroll
                for (int bj = 0; bj < 2; ++bj) { f32x4 v0 = acc[ai][bj][m][0], v1 = acc[ai][bj][m][1];
#pragma unroll
                    for (int e = 0; e < 4; ++e) {
                        if (ACT == 1 || ACT == 2) { v0[e] = gelu_t(v0[e]); v1[e] = gelu_t(v1[e]); }
                        if (ACT == 3) { v0[e] = silu(v0[e]); v1[e] = silu(v1[e]); }
                        if (ACT == 4) { v0[e] = v0[e] * 0.0625f; v1[e] = v1[e] * 0.0625f; }
                        if (ACT == 5) { v0[e] = sigm(v0[e]); v1[e] = sigm(v1[e]); } }
                    if (ACT == 2) { s += hsum4(v0) + hsum4(v1); q += dot4(v0, v0) + dot4(v1, v1); }
                    u32x4 w; w.x = pk2(v0[0], v0[1]); w.y = pk2(v0[2], v0[3]); w.z = pk2(v1[0], v1[1]); w.w = pk2(v1[2], v1[3]);
                    *(u32x4*)(zb + row * LDZ + bj * 128) = w; }
                if (ACT == 2) { s += __shfl_xor(s, 16); s += __shfl_xor(s, 32); q += __shfl_xor(q, 16); q += __shfl_xor(q, 32);
                    if (fq == 0) *(f32x2*)(statv + (row * 32 + (pn - 8) * 4 + wc) * 2) = (f32x2){s, q}; } }
    }
    __device__ __forceinline__ void rot(const f32x4 (&acc)[2][2][4][2], int pn, int row0, int wc, int fq) const {
        const float sc = (pn >= 32) ? 0.0625f : 1.0f; bf16_t* zb = Z + (size_t)pn * 256 + wc * 32 + 8 * fq;
#pragma unroll
        for (int ai = 0; ai < 2; ++ai)
#pragma unroll
            for (int m = 0; m < 4; ++m) { const int row = row0 + ai * 128 + m * 16; const int p = row < MP ? (row & 2047) : 2048; const size_t ti = (size_t)p * 128 + wc * 32 + 8 * fq;
                const f32x4 c0 = *(const f32x4*)(ropec + ti) * sc, c1 = *(const f32x4*)(ropec + ti + 4) * sc, s0 = *(const f32x4*)(ropes + ti) * sc, s1 = *(const f32x4*)(ropes + ti + 4) * sc;
                const f32x4 a0 = acc[ai][0][m][0], a1 = acc[ai][0][m][1], b0 = acc[ai][1][m][0], b1 = acc[ai][1][m][1];
                const f32x4 x0 = a0 * c0 - b0 * s0, x1 = a1 * c1 - b1 * s1, y0 = a0 * s0 + b0 * c0, y1 = a1 * s1 + b1 * c1;
                u32x4 w; w.x = pk2(x0[0], x0[1]); w.y = pk2(x0[2], x0[3]); w.z = pk2(x1[0], x1[1]); w.w = pk2(x1[2], x1[3]);
                *(u32x4*)(zb + (size_t)row * LDZ) = w;
                w.x = pk2(y0[0], y0[1]); w.y = pk2(y0[2], y0[3]); w.z = pk2(y1[0], y1[1]); w.w = pk2(y1[2], y1[3]);
                *(u32x4*)(zb + (size_t)row * LDZ + 128) = w;
                asm volatile("" ::: "memory"); }
    }
    __device__ __forceinline__ void operator()(f32x4 (&acc)[2][2][4][2], const pg8::Unit& u, int wr, int wc, int fr, int fq) const {
        const int row0 = u.pm * 256 + wr * 64 + fr;
        const int pn = I8 ? (u.pn < 32 ? u.pn : u.pn + 16) : u.pn;
        if (I8) {
            if (u.pm == 32 && pn >= 8 && pn < 16) return;
            const int col0 = pn * 256 + wc * 32 + 8 * fq; f32x4 swv[2][2];
#pragma unroll
            for (int bj = 0; bj < 2; ++bj)
#pragma unroll
                for (int n = 0; n < 2; ++n) swv[bj][n] = *(const f32x4*)(sw + col0 + bj * 128 + 4 * n);
#pragma unroll
            for (int ai = 0; ai < 2; ++ai)
#pragma unroll
                for (int m = 0; m < 4; ++m) { const float hs = sh[row0 + ai * 128 + m * 16];
#pragma unroll
                    for (int bj = 0; bj < 2; ++bj)
#pragma unroll
                        for (int n = 0; n < 2; ++n) { const i32x4 q = __builtin_bit_cast(i32x4, acc[ai][bj][m][n]);
                            acc[ai][bj][m][n] = (f32x4){(float)q[0], (float)q[1], (float)q[2], (float)q[3]} * (swv[bj][n] * hs); } }
        }
        if (pn < 8) ew<1>(acc, pn, row0, wc, fq);
        else if (pn < 16) ew<2>(acc, pn, row0, wc, fq);
        else if (pn < 24 || (pn >= 48 && pn < 56) || (pn >= 60 && pn < 64)) ew<3>(acc, pn, row0, wc, fq);
        else if (pn < 40) rot(acc, pn, row0, wc, fq);
        else if (pn < 48) ew<0>(acc, pn, row0, wc, fq);
        else if (pn < 60) ew<4>(acc, pn, row0, wc, fq);
        else ew<5>(acc, pn, row0, wc, fq);
    }
};
struct EpiMem {
    static constexpr bool PERM = true;
    float* omk; float* omv; bf16_t* mkv;
    __device__ __forceinline__ void operator()(f32x4 (&acc)[2][2][4][2], const pg8::Unit& u, int wr, int wc, int fr, int fq) const {
        const int row0 = u.pm * 256 + wr * 64 + fr;
        const int colt = u.pn * 256 + wc * 32 + 8 * fq; float* ob = (u.pn < 4) ? omk : omv; const int cc = colt & 1023;
#pragma unroll
        for (int ai = 0; ai < 2; ++ai)
#pragma unroll
            for (int m = 0; m < 4; ++m) { const size_t row = (size_t)(row0 + ai * 128 + m * 16);
#pragma unroll
                for (int bj = 0; bj < 2; ++bj) { const f32x4 v0 = acc[ai][bj][m][0], v1 = acc[ai][bj][m][1];
                    *(f32x4*)(ob + row * 1024 + cc + bj * 128) = v0; *(f32x4*)(ob + row * 1024 + cc + bj * 128 + 4) = v1;
                    u32x4 w; w.x = pk2(v0[0], v0[1]); w.y = pk2(v0[2], v0[3]); w.z = pk2(v1[0], v1[1]); w.w = pk2(v1[2], v1[3]);
                    *(u32x4*)(mkv + row * 2048 + colt + bj * 128) = w; } }
    }
};
struct EpiMerge {
    static constexpr bool PERM = true;
    const bf16_t* Z; bf16_t* MG; int pass;
    __device__ __forceinline__ void operator()(f32x4 (&acc)[2][2][4][2], const pg8::Unit& u, int wr, int wc, int fr, int fq) const {
        const int row0 = u.pm * 256 + wr * 64 + fr, col0 = u.pn * 256 + wc * 32 + 8 * fq;
#pragma unroll
        for (int ai = 0; ai < 2; ++ai)
#pragma unroll
            for (int m = 0; m < 4; ++m) { const size_t row = (size_t)(row0 + ai * 128 + m * 16);
#pragma unroll
                for (int bj = 0; bj < 2; ++bj) { const int c = col0 + bj * 128;
                    const u32x4 g = *(const u32x4*)(Z + row * LDZ + ZC_GS + pass * D + c);
                    f32x4 v0 = acc[ai][bj][m][0] * (f32x4){bflo(g.x), bfhi(g.x), bflo(g.y), bfhi(g.y)}, v1 = acc[ai][bj][m][1] * (f32x4){bflo(g.z), bfhi(g.z), bflo(g.w), bfhi(g.w)};
                    if (pass) { const u32x4 p = *(const u32x4*)(MG + row * D + c); v0 += (f32x4){bflo(p.x), bfhi(p.x), bflo(p.y), bfhi(p.y)}; v1 += (f32x4){bflo(p.z), bfhi(p.z), bflo(p.w), bfhi(p.w)}; }
                    u32x4 w; w.x = pk2(v0[0], v0[1]); w.y = pk2(v0[2], v0[3]); w.z = pk2(v1[0], v1[1]); w.w = pk2(v1[2], v1[3]);
                    *(u32x4*)(MG + row * D + c) = w; } }
    }
};
struct EpiOut {
    static constexpr bool PERM = false;
    const float* X; float* Y; float* stato;
    __device__ __forceinline__ void operator()(f32x4 (&acc)[2][2][4][2], const pg8::Unit& u, int wr, int wc, int fr, int fq) const {
        const int row0 = u.pm * 256 + wr * 64 + fr, col0 = u.pn * 256 + wc * 32 + 4 * fq;
#pragma unroll
        for (int ai = 0; ai < 2; ++ai)
#pragma unroll
            for (int m = 0; m < 4; ++m) { const size_t row = (size_t)(row0 + ai * 128 + m * 16); float q = 0.f;
#pragma unroll
                for (int bj = 0; bj < 2; ++bj)
#pragma unroll
                    for (int n = 0; n < 2; ++n) { const size_t o = row * D + col0 + bj * 128 + n * 16; const f32x4 v = *(const f32x4*)(X + o) + acc[ai][bj][m][n]; *(f32x4*)(Y + o) = v; q += dot4(v, v); }
                q += __shfl_xor(q, 16); q += __shfl_xor(q, 32);
                if (fq == 0) stato[row * 64 + u.pn * 4 + wc] = q; }
    }
};

struct EpiMerge8 {
    static constexpr bool PERM = true;
    const bf16_t* Z; bf16_t* MG; const float* sx; const float* sw; int pass;
    __device__ __forceinline__ void operator()(f32x4 (&acc)[2][2][4][2], const pg8::Unit& u, int wr, int wc, int fr, int fq) const {
        const int row0 = u.pm * 256 + wr * 64 + fr, col0 = u.pn * 256 + wc * 32 + 8 * fq; f32x4 swv[2][2];
#pragma unroll
        for (int bj = 0; bj < 2; ++bj)
#pragma unroll
            for (int n = 0; n < 2; ++n) swv[bj][n] = *(const f32x4*)(sw + col0 + bj * 128 + 4 * n);
#pragma unroll
        for (int ai = 0; ai < 2; ++ai)
#pragma unroll
            for (int m = 0; m < 4; ++m) { const size_t row = (size_t)(row0 + ai * 128 + m * 16); const float hs = sx[row];
#pragma unroll
                for (int bj = 0; bj < 2; ++bj) { const int c = col0 + bj * 128;
                    const u32x4 g = *(const u32x4*)(Z + row * LDZ + ZC_GS + pass * D + c);
                    const i32x4 q0 = __builtin_bit_cast(i32x4, acc[ai][bj][m][0]), q1 = __builtin_bit_cast(i32x4, acc[ai][bj][m][1]);
                    f32x4 v0 = (f32x4){(float)q0[0], (float)q0[1], (float)q0[2], (float)q0[3]} * (swv[bj][0] * hs) * (f32x4){bflo(g.x), bfhi(g.x), bflo(g.y), bfhi(g.y)};
                    f32x4 v1 = (f32x4){(float)q1[0], (float)q1[1], (float)q1[2], (float)q1[3]} * (swv[bj][1] * hs) * (f32x4){bflo(g.z), bfhi(g.z), bflo(g.w), bfhi(g.w)};
                    if (pass) { const u32x4 p = *(const u32x4*)(MG + row * D + c); v0 += (f32x4){bflo(p.x), bfhi(p.x), bflo(p.y), bfhi(p.y)}; v1 += (f32x4){bflo(p.z), bfhi(p.z), bflo(p.w), bfhi(p.w)}; }
                    u32x4 w; w.x = pk2(v0[0], v0[1]); w.y = pk2(v0[2], v0[3]); w.z = pk2(v1[0], v1[1]); w.w = pk2(v1[2], v1[3]);
                    *(u32x4*)(MG + row * D + c) = w; } }
    }
};
struct EpiOut8 {
    static constexpr bool PERM = false;
    const float* X; float* Y; float* stato; const float* sx; const float* sw;
    __device__ __forceinline__ void operator()(f32x4 (&acc)[2][2][4][2], const pg8::Unit& u, int wr, int wc, int fr, int fq) const {
        const int row0 = u.pm * 256 + wr * 64 + fr, col0 = u.pn * 256 + wc * 32 + 4 * fq; f32x4 swv[2][2];
#pragma unroll
        for (int bj = 0; bj < 2; ++bj)
#pragma unroll
            for (int n = 0; n < 2; ++n) swv[bj][n] = *(const f32x4*)(sw + col0 + bj * 128 + n * 16);
#pragma unroll
        for (int ai = 0; ai < 2; ++ai)
#pragma unroll
            for (int m = 0; m < 4; ++m) { const size_t row = (size_t)(row0 + ai * 128 + m * 16); float q = 0.f; const float hs = sx[row];
#pragma unroll
                for (int bj = 0; bj < 2; ++bj)
#pragma unroll
                    for (int n = 0; n < 2; ++n) { const size_t o = row * D + col0 + bj * 128 + n * 16; const i32x4 qi = __builtin_bit_cast(i32x4, acc[ai][bj][m][n]);
                        const f32x4 v = *(const f32x4*)(X + o) + (f32x4){(float)qi[0], (float)qi[1], (float)qi[2], (float)qi[3]} * (swv[bj][n] * hs); *(f32x4*)(Y + o) = v; q += dot4(v, v); }
                q += __shfl_xor(q, 16); q += __shfl_xor(q, 32);
                if (fq == 0) stato[row * 64 + u.pn * 4 + wc] = q; }
    }
};

__device__ __forceinline__ void p0_load_tile(float (&v)[32], const float* W, int N, int k0, int n0, int lane) {
    const float* src = W + (size_t)(k0 + (lane >> 5)) * N + n0 + (lane & 31);
#pragma unroll
    for (int i = 0; i < 32; ++i) v[i] = __builtin_nontemporal_load(src + (size_t)(2 * i) * N);
}
template <int MODE> __device__ __forceinline__ void p0_transpose_tile(const float* W, int K, int N, int k0, int n0, bf16_t* WT, int nd0, LAS float* scr, int lane) {
    float v[32]; p0_load_tile(v, W, N, k0, n0, lane);
#pragma unroll
    for (int i = 0; i < 32; ++i) scr[(2 * i + (lane >> 5)) * 33 + (lane & 31)] = v[i];
    LDS_WAIT();
    const int c = lane & 7;
#pragma unroll
    for (int j = 0; j < 4; ++j) { const int n = (lane >> 3) + 8 * j; const LAS float* s = scr + (8 * c) * 33 + n;
        u32x4 o; o.x = pk2(s[0 * 33], s[1 * 33]); o.y = pk2(s[2 * 33], s[3 * 33]); o.z = pk2(s[4 * 33], s[5 * 33]); o.w = pk2(s[6 * 33], s[7 * 33]);
        if (MODE == 0) *(u32x4*)(WT + (size_t)(nd0 + n) * K + k0 + 8 * c) = o;
        else { const int nn = nd0 + n; *(u32x4*)((unsigned char*)WT + img_off(MODE == 2 ? perm_slot(nn) : nn, k0 + 8 * c, K)) = o; } }
    LDS_WAIT();
}
template <int MODE> __device__ __forceinline__ void p0_transpose_item(const float* W, int K, int N, bf16_t* WT, LAS float* scr, int item, int lane) {
    const int nblk = N / 32, kb = item / nblk, nb = item % nblk; p0_transpose_tile<MODE>(W, K, N, 64 * kb, 32 * nb, WT, 32 * nb, scr, lane);
}
__device__ __forceinline__ int i8_col0(int nb8) { return nb8 < 256 ? nb8 * 32 : nb8 * 32 + 4096; }
__device__ __forceinline__ void p0_absmax_item(const Frame& F, int item, int lane) {
    const int kb = item / 768, nb8 = item % 768, n0 = i8_col0(nb8);
    float v[32]; p0_load_tile(v, F.w_in, NIN, 64 * kb, n0, lane); float m = 0.f;
#pragma unroll
    for (int i = 0; i < 32; ++i) m = fmaxf(m, fabsf(v[i]));
    m = fmaxf(m, __shfl_xor(m, 32));
    if (lane < 32) atomicMax(F.CMAX + n0 + lane, __float_as_uint(m));
}
__device__ __forceinline__ void p0_quant_item(const Frame& F, LAS float* scr, int item, int lane) {
    const int kb = item / 768, nb8 = item % 768, n0 = i8_col0(nb8), k0 = 64 * kb;
    float v[32]; p0_load_tile(v, F.w_in, NIN, k0, n0, lane);
    const float amax = __uint_as_float(F.CMAX[n0 + (lane & 31)]); const float sc = amax > 0.f ? 127.0f / amax : 0.f;
    if (kb == 0 && lane < 32) F.SW[n0 + lane] = amax * (1.0f / 127.0f);
    LAS int* si = (LAS int*)scr;
#pragma unroll
    for (int i = 0; i < 32; ++i) si[(2 * i + (lane >> 5)) * 33 + (lane & 31)] = (int)__builtin_rintf(v[i] * sc);
    LDS_WAIT();
    const int c = lane & 7;
#pragma unroll
    for (int j = 0; j < 4; ++j) { const int n = (lane >> 3) + 8 * j; const LAS int* q = si + (8 * c) * 33 + n;
        u32x2 o; o.x = (unsigned)(q[0] & 0xff) | ((unsigned)(q[33] & 0xff) << 8) | ((unsigned)(q[66] & 0xff) << 16) | ((unsigned)(q[99] & 0xff) << 24);
        o.y = (unsigned)(q[132] & 0xff) | ((unsigned)(q[165] & 0xff) << 8) | ((unsigned)(q[198] & 0xff) << 16) | ((unsigned)(q[231] & 0xff) << 24);
        *(u32x2*)(F.W8 + img8_off(perm_slot(nb8 * 32 + n), k0 + 8 * c, D)) = o; }
    LDS_WAIT();
}
template <bool Q8> __device__ __forceinline__ void rms_row(const float* xrow, const float* g, bf16_t* obase, int m, int lane, unsigned char* o8, float* sh) {
    const f32x4* xr = (const f32x4*)xrow + lane; f32x4 v[16]; float s = 0.f;
#pragma unroll
    for (int j = 0; j < 16; ++j) { v[j] = xr[64 * j]; s += dot4(v[j], v[j]); }
    const float r = 1.0f / sqrtf(wave_sum(s) * (1.0f / 4096.0f) + EPS);
    const f32x4* gr = (const f32x4*)g + lane; float am = 0.f;
#pragma unroll
    for (int j = 0; j < 16; ++j) { v[j] = v[j] * r * gr[64 * j]; *(u32x2*)((unsigned char*)obase + img_off(m, 4 * lane + 256 * j, D)) = pack4(v[j]);
        if (Q8) am = fmaxf(am, fmaxf(fmaxf(fabsf(v[j][0]), fabsf(v[j][1])), fmaxf(fabsf(v[j][2]), fabsf(v[j][3])))); }
    if (Q8) { am = wave_max(am); const float sc = am > 0.f ? 127.0f / am : 0.f; if (lane == 0) sh[m] = am * (1.0f / 127.0f);
#pragma unroll
        for (int j = 0; j < 16; ++j) { const int q0 = (int)__builtin_rintf(v[j][0] * sc), q1 = (int)__builtin_rintf(v[j][1] * sc), q2 = (int)__builtin_rintf(v[j][2] * sc), q3 = (int)__builtin_rintf(v[j][3] * sc);
            *(unsigned*)(o8 + img8_off(m, 4 * lane + 256 * j, D)) = (unsigned)(q0 & 0xff) | ((unsigned)(q1 & 0xff) << 8) | ((unsigned)(q2 & 0xff) << 16) | ((unsigned)(q3 & 0xff) << 24); } }
}
template <int K> __device__ __forceinline__ void quant_row(const bf16_t* src, unsigned char* dst, int slot, float* sc, int lane) {
    constexpr int NCH = K / 512; u32x4 raw[NCH]; float am = 0.f;
#pragma unroll
    for (int i = 0; i < NCH; ++i) { raw[i] = *(const u32x4*)(src + 8 * (lane + 64 * i));
        const unsigned w[4] = {raw[i].x, raw[i].y, raw[i].z, raw[i].w};
#pragma unroll
        for (int e = 0; e < 4; ++e) am = fmaxf(am, fmaxf(fabsf(bflo(w[e])), fabsf(bfhi(w[e])))); }
    am = wave_max(am); const float s = am > 0.f ? 127.0f / am : 0.f; if (lane == 0) *sc = am * (1.0f / 127.0f);
#pragma unroll
    for (int i = 0; i < NCH; ++i) { const unsigned w[4] = {raw[i].x, raw[i].y, raw[i].z, raw[i].w}; unsigned o[2];
#pragma unroll
        for (int h = 0; h < 2; ++h) { const int q0 = (int)__builtin_rintf(bflo(w[2 * h]) * s), q1 = (int)__builtin_rintf(bfhi(w[2 * h]) * s), q2 = (int)__builtin_rintf(bflo(w[2 * h + 1]) * s), q3 = (int)__builtin_rintf(bfhi(w[2 * h + 1]) * s);
            o[h] = (unsigned)(q0 & 0xff) | ((unsigned)(q1 & 0xff) << 8) | ((unsigned)(q2 & 0xff) << 16) | ((unsigned)(q3 & 0xff) << 24); }
        *(u32x2*)(dst + img8_off(slot, 8 * (lane + 64 * i), K)) = (u32x2){o[0], o[1]}; }
}
__device__ __forceinline__ void p0a_prologue(const Frame& F) {
    LAS float* scr = (LAS float*)(F.lds + F.wave * 8448);
    const int gw = F.cu * 8 + F.wave, NGW = F.G * 8;
    constexpr int I_AMAX = 64 * 768, I_STR = 64 * 192, I_MEM = (D / 64) * (2048 / 32), I_OA = (AW / 64) * (D / 32), I_OB = (RW / 64) * (D / 32), I_OC = (MW / 64) * (D / 32), I_OUT = (D / 64) * (D / 32);
    constexpr int NITEMS = I_AMAX + I_STR + I_MEM + I_OA + I_OB + I_OC + I_OUT;
    for (int it = gw; it < NITEMS; it += NGW) {
        int r = it;
        if (r < I_AMAX) { p0_absmax_item(F, r, F.lane); continue; } r -= I_AMAX;
        if (r < I_STR) { const int kb = r / 192, nb = r % 192; const int n0 = nb < 64 ? 2048 + nb * 32 : 8192 + (nb - 64) * 32;
            p0_transpose_tile<2>(F.w_in, D, NIN, 64 * kb, n0, F.WinT, n0, scr, F.lane); continue; } r -= I_STR;
        if (r < I_MEM) { p0_transpose_item<2>(F.w_mem, D, 2048, F.WmemT, scr, r, F.lane); continue; } r -= I_MEM;
        if (r < I_OA) { p0_transpose_item<0>(F.w_oa, AW, D, F.WoaT, scr, r, F.lane); continue; } r -= I_OA;
        if (r < I_OB) { p0_transpose_item<0>(F.w_ob, RW, D, F.WobT, scr, r, F.lane); continue; } r -= I_OB;
        if (r < I_OC) { p0_transpose_item<0>(F.w_oc, MW, D, F.WocT, scr, r, F.lane); continue; } r -= I_OC;
        p0_transpose_item<0>(F.w_out, D, D, F.WoutT, scr, r, F.lane);
    }
    for (int m = gw; m < MPAD + 1024; m += NGW) {
        if (m < MP) rms_row<true>(F.xp + (size_t)m * D, F.g_pre, F.H, m, F.lane, F.H8, F.SH);
        else if (m < MREAL) rms_row<true>(F.xs + (size_t)(m - MP) * D, F.g_pre, F.H, m, F.lane, F.H8, F.SH);
        else if (m < MPAD) { u32x4* o = (u32x4*)((unsigned char*)F.H + (size_t)(MREAL >> 7) * 64 * 16384 + (size_t)(m - MREAL) * 8192) + F.lane;
#pragma unroll
            for (int j = 0; j < 8; ++j) o[64 * j] = (u32x4){0u, 0u, 0u, 0u};
            u32x4* o2 = (u32x4*)(F.H8 + (size_t)(MREAL >> 7) * 32 * 16384 + (size_t)(m - MREAL) * 4096) + F.lane;
#pragma unroll
            for (int j = 0; j < 4; ++j) o2[64 * j] = (u32x4){0u, 0u, 0u, 0u};
            if (F.lane == 0) F.SH[m] = 0.f; }
        else rms_row<false>(F.memp + (size_t)(m - MPAD) * D, F.g_mem, F.MEMN, m - MPAD, F.lane, nullptr, nullptr);
    }
    for (int idx = F.cu * 512 + F.tid; idx < 2049 * 128; idx += F.G * 512) {
        const int p = idx >> 7, j = idx & 127; const int pos = p < 2048 ? p : 16384;
        double iv = 1.0, bs = 0.9305720409296989; for (int e = j; e > 0; e >>= 1) { if (e & 1) iv *= bs; bs *= bs; }
        const float inv = (float)iv; const float ang = (float)pos * inv;
        const double x = (double)ang; const double n = __builtin_rint(x * 0.15915494309189535);
        const double r = __builtin_fma(-n, 2.4492935982947064e-16, __builtin_fma(-n, 6.283185307179586, x)); const double r2 = r * r;
        double sn = r, tm = r, cs = 1.0, tc = 1.0;
#pragma unroll
        for (int k = 1; k <= 13; ++k) { tm *= -r2 * (1.0 / (double)((2 * k) * (2 * k + 1))); sn += tm; tc *= -r2 * (1.0 / (double)((2 * k - 1) * (2 * k))); cs += tc; }
        F.ropec[idx] = (float)cs; F.ropes[idx] = (float)sn;
    }
}

template <int NROWS>
__device__ __forceinline__ void stage_tile256(LAS unsigned char* img, const bf16_t* src, size_t ld, int tid) {
    constexpr int PER = NROWS * 32 / 512;
#pragma unroll
    for (int b0 = 0; b0 < PER; b0 += 8) {
        u32x4 v[8];
#pragma unroll
        for (int i = 0; i < 8; ++i) { const int ch = tid + 512 * (b0 + i), row = ch >> 5, cc = ch & 31; v[i] = *(const u32x4*)(src + (size_t)row * ld + cc * 8); }
#pragma unroll
        for (int i = 0; i < 8; ++i) { const int ch = tid + 512 * (b0 + i), row = ch >> 5, cc = ch & 31; *(LAS u32x4*)(img + row * IMG_PITCH + cc * 16) = v[i]; }
    }
}

__device__ __forceinline__ void scan_unit(const Frame& F, int b, int h, int sl) {
    LAS unsigned char* imgK = F.lds; LAS unsigned char* imgV = F.lds + 67584;
    const int w = F.wave, tid = launder(F.tid), lane = tid & 63, fr = lane & 15, fq = lane >> 4;
    const float l2g = log2gamma(h); const float dblk = ex2(128.0f * l2g);
    f32x4 acc[2][2];
#pragma unroll
    for (int a = 0; a < 2; ++a)
#pragma unroll
        for (int k = 0; k < 2; ++k) acc[a][k] = (f32x4){0.f, 0.f, 0.f, 0.f};
    for (int c = 0; c < 16; ++c) {
        const size_t r0 = (size_t)b * 2048 + c * 128;
        __syncthreads();
        stage_tile256<128>(imgK, F.Z + r0 * LDZ + ZC_K + h * 256, LDZ, tid);
        { const int j = tid >> 2, cc = tid & 3; const u32x4 raw = *(const u32x4*)(F.Z + (r0 + j) * LDZ + ZC_RV + h * 256 + sl * 32 + cc * 8);
          const float sc = ex2((float)(127 - j) * l2g);
          u32x4 o; o.x = pk2(bflo(raw.x) * sc, bfhi(raw.x) * sc); o.y = pk2(bflo(raw.y) * sc, bfhi(raw.y) * sc); o.z = pk2(bflo(raw.z) * sc, bfhi(raw.z) * sc); o.w = pk2(bflo(raw.w) * sc, bfhi(raw.w) * sc);
          *(LAS u32x4*)(imgV + j * 80 + cc * 16) = o; }
        __syncthreads();
#pragma unroll
        for (int a = 0; a < 2; ++a)
#pragma unroll
            for (int k = 0; k < 2; ++k) acc[a][k] = acc[a][k] * dblk;
#pragma unroll
        for (int s = 0; s < 4; ++s) {
            bf16x8 fv[2], fk[2];
#pragma unroll
            for (int a = 0; a < 2; ++a) { fv[a] = tr_frag(imgV, 80, 32 * s, 16 * a, lane); fk[a] = tr_frag(imgK, IMG_PITCH, 32 * s, 32 * w + 16 * a, lane); }
#pragma unroll
            for (int a = 0; a < 2; ++a)
#pragma unroll
                for (int k = 0; k < 2; ++k) acc[a][k] = mma(acc[a][k], fk[k], fv[a]);
        }
        if (c < 15) {
            bf16_t* rs = F.RS + ((size_t)(b * 8 + h) * 15 + c) * 65536;
#pragma unroll
            for (int a = 0; a < 2; ++a)
#pragma unroll
                for (int k = 0; k < 2; ++k) *(u32x2*)(rs + (size_t)(sl * 32 + 16 * a + fr) * 256 + 32 * w + 16 * k + 4 * fq) = pack4(acc[a][k]);
        }
    }
    float* rp = F.out + O_RP + (size_t)(b * 8 + h) * 65536;
#pragma unroll
    for (int a = 0; a < 2; ++a)
#pragma unroll
        for (int k = 0; k < 2; ++k)
#pragma unroll
            for (int e = 0; e < 4; ++e) rp[(size_t)(32 * w + 16 * k + 4 * fq + e) * 256 + sl * 32 + 16 * a + fr] = acc[a][k][e];
}

__device__ __forceinline__ void spatial_unit(const Frame& F, int b, int c, int g, int hf) {
    LAS unsigned char* img = F.lds; LAS float* st = (LAS float*)(F.lds + SMALL_OFF);
    const int w = F.wave, tid = launder(F.tid), lane = tid & 63, fr = lane & 15, fq = lane >> 4;
    const size_t r0 = (size_t)b * 2048 + c * 128; const int ch0 = g * 512 + hf * 256;
    __syncthreads();
    if (tid < 128) { const f32x4* p = (const f32x4*)(F.statv + (r0 + tid) * 64); float s = 0.f, q = 0.f;
#pragma unroll
        for (int k = 0; k < 16; ++k) { const f32x4 t = p[k]; s += t[0] + t[2]; q += t[1] + t[3]; }
        const float mu = s * (1.0f / 2048.0f); const float var = fmaxf(q * (1.0f / 2048.0f) - mu * mu, 0.f);
        st[2 * tid] = mu; st[2 * tid + 1] = 1.0f / sqrtf(var + EPS); }
    __syncthreads();
#pragma unroll
    for (int i = 0; i < 8; ++i) { const int chk = tid + 512 * i, row = chk >> 5, cc = chk & 31;
        const u32x4 raw = *(const u32x4*)(F.Z + (r0 + row) * LDZ + ZC_V + ch0 + cc * 8);
        const f32x4 ga = *(const f32x4*)(F.g_anorm + ch0 + cc * 8), gb = *(const f32x4*)(F.g_anorm + ch0 + cc * 8 + 4);
        const float mu = st[2 * row], rs = st[2 * row + 1];
        u32x4 o; o.x = pk2((bflo(raw.x) - mu) * rs * ga[0], (bfhi(raw.x) - mu) * rs * ga[1]); o.y = pk2((bflo(raw.y) - mu) * rs * ga[2], (bfhi(raw.y) - mu) * rs * ga[3]);
        o.z = pk2((bflo(raw.z) - mu) * rs * gb[0], (bfhi(raw.z) - mu) * rs * gb[1]); o.w = pk2((bflo(raw.w) - mu) * rs * gb[2], (bfhi(raw.w) - mu) * rs * gb[3]);
        *(LAS u32x4*)(img + row * IMG_PITCH + cc * 16) = o; }
    __syncthreads();
    const int i = 16 * w + fr;
    bf16x8 fw[4];
#pragma unroll
    for (int s = 0; s < 4; ++s) { const int j0 = 32 * s + 8 * fq; const float* wp = F.w_s + (size_t)g * 16384 + i * 128 + j0; const f32x4 a = *(const f32x4*)wp, bq = *(const f32x4*)(wp + 4);
        float t[8] = {a[0], a[1], a[2], a[3], bq[0], bq[1], bq[2], bq[3]};
#pragma unroll
        for (int e = 0; e < 8; ++e) t[e] = (j0 + e <= i) ? t[e] : 0.f;
        const unsigned p0 = pk2(t[0], t[1]), p1 = pk2(t[2], t[3]), p2 = pk2(t[4], t[5]), p3 = pk2(t[6], t[7]);
        const u32x4 pw = (u32x4){p0, p1, p2, p3}; fw[s] = __builtin_bit_cast(bf16x8, pw); }
    f32x4 acc[16];
#pragma unroll
    for (int n = 0; n < 16; ++n) acc[n] = (f32x4){0.f, 0.f, 0.f, 0.f};
    const int smax = w >> 1;
#pragma unroll
    for (int s = 0; s < 4; ++s) if (s <= smax) {
#pragma unroll
        for (int n = 0; n < 16; ++n) { acc[n] = mma(acc[n], tr_frag(img, IMG_PITCH, 32 * s, 16 * n, lane), fw[s]); if ((n & 3) == 3) __builtin_amdgcn_sched_barrier(0); }
    }
    const float bsv = F.b_s[g * 128 + i]; const bf16_t* zr = F.Z + (r0 + i) * LDZ; bf16_t* ar = F.AACT + (r0 + i) * AW;
#pragma unroll
    for (int n = 0; n < 16; ++n) { const int ch = ch0 + 16 * n + 4 * fq;
        const f32x4 uu = unpk4(*(const u32x2*)(zr + ZC_U + ch)), ag = unpk4(*(const u32x2*)(zr + ZC_G + ch));
        *(u32x2*)(ar + ch) = pack4(uu * (acc[n] + bsv) * ag); }
}
__device__ __forceinline__ void spatial_sample_row(const Frame& F, int s) {
    const int lane = launder(F.lane); const size_t row = (size_t)MP + s;
    float sm = 0.f, sq = 0.f; if (lane < 32) { const f32x2 t = *(const f32x2*)(F.statv + (row * 32 + lane) * 2); sm = t[0]; sq = t[1]; }
    sm = wave_sum(sm); sq = wave_sum(sq);
    const float mu = sm * (1.0f / 2048.0f); const float rs = 1.0f / sqrtf(fmaxf(sq * (1.0f / 2048.0f) - mu * mu, 0.f) + EPS);
    const bf16_t* zr = F.Z + row * LDZ;
#pragma unroll
    for (int g = 0; g < 4; ++g) { const int ch = g * 512 + lane * 8;
        const u32x4 rv = *(const u32x4*)(zr + ZC_V + ch), ru = *(const u32x4*)(zr + ZC_U + ch), rg = *(const u32x4*)(zr + ZC_G + ch);
        const f32x4 ga = *(const f32x4*)(F.g_anorm + ch), gb = *(const f32x4*)(F.g_anorm + ch + 4);
        const f32x4 v0 = ((f32x4){bflo(rv.x), bfhi(rv.x), bflo(rv.y), bfhi(rv.y)} - mu) * rs * ga, v1 = ((f32x4){bflo(rv.z), bfhi(rv.z), bflo(rv.w), bfhi(rv.w)} - mu) * rs * gb;
        *(f32x4*)(F.out + O_GV + (size_t)s * AW + ch) = v0; *(f32x4*)(F.out + O_GV + (size_t)s * AW + ch + 4) = v1;
        const float w00 = F.w_s[g * 16384], b0 = F.b_s[g * 128];
        const f32x4 a0 = (f32x4){bflo(ru.x), bfhi(ru.x), bflo(ru.y), bfhi(ru.y)} * (v0 * w00 + b0) * (f32x4){bflo(rg.x), bfhi(rg.x), bflo(rg.y), bfhi(rg.y)};
        const f32x4 a1 = (f32x4){bflo(ru.z), bfhi(ru.z), bflo(ru.w), bfhi(ru.w)} * (v1 * w00 + b0) * (f32x4){bflo(rg.z), bfhi(rg.z), bflo(rg.w), bfhi(rg.w)};
        u32x4 o; o.x = pk2(a0[0], a0[1]); o.y = pk2(a0[2], a0[3]); o.z = pk2(a1[0], a1[1]); o.w = pk2(a1[2], a1[3]);
        *(u32x4*)(F.AACT + row * AW + ch) = o; }
}
__device__ __forceinline__ void ret_sample_item(const Frame& F, int req, int h) {
    LAS float* qs = (LAS float*)F.lds; LAS float* ks = qs + 256; LAS float* red = qs + 512;
    const int w = F.wave, tid = launder(F.tid), lane = tid & 63; const size_t row = (size_t)MP + req; const bf16_t* zr = F.Z + row * LDZ;
    __syncthreads();
    if (tid < 256) { qs[tid] = bf1(zr[ZC_Q + h * 256 + tid]); ks[tid] = bf1(zr[ZC_K + h * 256 + tid]); }
    const f32x4 vv = unpk4(*(const u32x2*)(zr + ZC_RV + h * 256 + lane * 4));
    __syncthreads();
    const float gam = 1.0f - ex2(-5.0f - (float)h);
    const size_t base = ((size_t)(req * 8 + h) * 256) * 256 + lane * 4; const float* sp = F.state + base; float* op = F.out + O_RS + base;
    f32x4 o = (f32x4){0.f, 0.f, 0.f, 0.f};
#pragma unroll
    for (int i0 = 0; i0 < 4; ++i0) { f32x4 R[8];
#pragma unroll
        for (int j = 0; j < 8; ++j) { const int d = w + 8 * (i0 * 8 + j); R[j] = __builtin_nontemporal_load((const f32x4*)(sp + (size_t)d * 256)); }
#pragma unroll
        for (int j = 0; j < 8; ++j) { const int d = w + 8 * (i0 * 8 + j); const f32x4 rn = R[j] * gam + vv * ks[d]; __builtin_nontemporal_store(rn, (f32x4*)(op + (size_t)d * 256)); o += rn * qs[d]; } }
    *(LAS f32x4*)(red + w * 256 + lane * 4) = o;
    __syncthreads();
    if (w == 0) { f32x4 t = *(LAS f32x4*)(red + lane * 4);
#pragma unroll
        for (int k = 1; k < 8; ++k) t += *(LAS f32x4*)(red + k * 256 + lane * 4);
        const float mean = wave_sum(hsum4(t)) * (1.0f / 256.0f); const f32x4 d = t - mean; const float var = wave_sum(dot4(d, d)) * (1.0f / 256.0f); const float rs = 1.0f / sqrtf(var + EPS);
        const f32x4 gr = *(const f32x4*)(F.g_ret + h * 256 + lane * 4), rg = unpk4(*(const u32x2*)(zr + ZC_RG + h * 256 + lane * 4));
        *(u32x2*)(F.BACT + row * RW + h * 256 + lane * 4) = pack4(d * rs * gr * rg); }
}
__device__ __forceinline__ void xattn_sample_item(const Frame& F, int req, int mh) {
    LAS float* cq = (LAS float*)F.lds; LAS float* sc = cq + 256; LAS float* red = cq + 512; LAS float* misc = cq + 512 + 2048;
    const int w = F.wave, tid = launder(F.tid), lane = tid & 63; const size_t row = (size_t)MP + req; const bf16_t* zr = F.Z + row * LDZ;
    __syncthreads();
    if (tid < 256) cq[tid] = bf1(zr[ZC_CQ + mh * 256 + tid]);
    __syncthreads();
    { const int sub = lane >> 4, li = lane & 15; f32x4 cqr[4];
#pragma unroll
      for (int c = 0; c < 4; ++c) cqr[c] = *(LAS f32x4*)(cq + 4 * (li + 16 * c));
#pragma unroll
      for (int g0 = 0; g0 < 8; g0 += 4) { f32x4 kk[4][4];
#pragma unroll
          for (int g = 0; g < 4; ++g) { const int m = 32 * w + 4 * (g0 + g) + sub; const float* kp = F.cmk + (((size_t)req * 256 + m) * 4 + mh) * 256;
#pragma unroll
              for (int c = 0; c < 4; ++c) kk[g][c] = __builtin_nontemporal_load((const f32x4*)(kp + 4 * (li + 16 * c))); }
#pragma unroll
          for (int g = 0; g < 4; ++g) { float dsum = (dot4(kk[g][0], cqr[0]) + dot4(kk[g][1], cqr[1])) + (dot4(kk[g][2], cqr[2]) + dot4(kk[g][3], cqr[3]));
              dsum += __shfl_xor(dsum, 1); dsum += __shfl_xor(dsum, 2); dsum += __shfl_xor(dsum, 4); dsum += __shfl_xor(dsum, 8);
              if (li == 0) sc[32 * w + 4 * (g0 + g) + sub] = dsum; } } }
    __syncthreads();
    if (w == 0) { f32x4 s4 = *(LAS f32x4*)(sc + 4 * lane); const float mx = wave_max(fmaxf(fmaxf(s4[0], s4[1]), fmaxf(s4[2], s4[3])));
#pragma unroll
        for (int e = 0; e < 4; ++e) s4[e] = ex2((s4[e] - mx) * 1.4426950408889634f);
        const float sum = wave_sum(hsum4(s4)); *(LAS f32x4*)(sc + 4 * lane) = s4; if (lane == 0) misc[0] = 1.0f / sum; }
    __syncthreads();
    f32x4 o = (f32x4){0.f, 0.f, 0.f, 0.f};
#pragma unroll
    for (int i0 = 0; i0 < 4; ++i0) { f32x4 V[8];
#pragma unroll
        for (int j = 0; j < 8; ++j) { const int m = w + 8 * (i0 * 8 + j); V[j] = __builtin_nontemporal_load((const f32x4*)(F.cmv + (((size_t)req * 256 + m) * 4 + mh) * 256 + lane * 4)); }
#pragma unroll
        for (int j = 0; j < 8; ++j) { const int m = w + 8 * (i0 * 8 + j); o += V[j] * sc[m]; } }
    *(LAS f32x4*)(red + w * 256 + lane * 4) = o;
    __syncthreads();
    if (w == 0) { f32x4 t = *(LAS f32x4*)(red + lane * 4);
#pragma unroll
        for (int k = 1; k < 8; ++k) t += *(LAS f32x4*)(red + k * 256 + lane * 4);
        const f32x4 cg = unpk4(*(const u32x2*)(zr + ZC_CG + mh * 256 + lane * 4));
        *(u32x2*)(F.CACT + row * MW + mh * 256 + lane * 4) = pack4(t * misc[0] * cg); }
}

__device__ __forceinline__ void ret_out_unit(const Frame& F, int b, int h, int c) {
    LAS unsigned char* img = F.lds; const int w = F.wave, tid = launder(F.tid), lane = tid & 63, fr = lane & 15, fq = lane >> 4;
    LAS unsigned char* Pw = F.lds + 67584 + w * 4352;
    const size_t r0 = (size_t)b * 2048 + c * 128; const int i = 16 * w + fr; const float l2g = log2gamma(h);
    bf16x8 qf[8];
#pragma unroll
    for (int s = 0; s < 8; ++s) qf[s] = *(const bf16x8*)(F.Z + (r0 + i) * LDZ + ZC_Q + h * 256 + 32 * s + 8 * fq);
    f32x4 acc[16];
#pragma unroll
    for (int n = 0; n < 16; ++n) acc[n] = (f32x4){0.f, 0.f, 0.f, 0.f};
    __syncthreads();
    if (c > 0) {
        stage_tile256<256>(img, F.RS + ((size_t)(b * 8 + h) * 15 + (c - 1)) * 65536, 256, tid);
        __syncthreads();
#pragma unroll
        for (int n = 0; n < 16; ++n) {
#pragma unroll
            for (int s = 0; s < 8; ++s) acc[n] = mma(acc[n], *(const LAS bf16x8*)(img + (16 * n + fr) * IMG_PITCH + (32 * s + 8 * fq) * 2), qf[s]);
            __builtin_amdgcn_sched_barrier(0); }
        const float dq = ex2((float)(i + 1) * l2g);
#pragma unroll
        for (int n = 0; n < 16; ++n) acc[n] = acc[n] * dq;
        __syncthreads();
    }
    stage_tile256<128>(img, F.Z + r0 * LDZ + ZC_K + h * 256, LDZ, tid);
    __syncthreads();
#pragma unroll
    for (int n = 0; n < 8; ++n) {
        f32x4 sa = (f32x4){0.f, 0.f, 0.f, 0.f};
        if (n <= w) {
#pragma unroll
            for (int s = 0; s < 8; ++s) sa = mma(sa, *(const LAS bf16x8*)(img + (16 * n + fr) * IMG_PITCH + (32 * s + 8 * fq) * 2), qf[s]);
#pragma unroll
            for (int e = 0; e < 4; ++e) { const int dij = i - (16 * n + 4 * fq + e); sa[e] = dij >= 0 ? sa[e] * ex2((float)dij * l2g) : 0.f; }
        }
        *(LAS u32x2*)(Pw + fr * 272 + (16 * n + 4 * fq) * 2) = pack4(sa); __builtin_amdgcn_sched_barrier(0);
    }
    __syncthreads();
    stage_tile256<128>(img, F.Z + r0 * LDZ + ZC_RV + h * 256, LDZ, tid);
    __syncthreads();
    const int smax = w >> 1;
#pragma unroll
    for (int s = 0; s < 4; ++s) if (s <= smax) {
        const bf16x8 pf = *(const LAS bf16x8*)(Pw + fr * 272 + (32 * s + 8 * fq) * 2);
#pragma unroll
        for (int n = 0; n < 16; ++n) { acc[n] = mma(acc[n], tr_frag(img, IMG_PITCH, 32 * s, 16 * n, lane), pf); if ((n & 3) == 3) __builtin_amdgcn_sched_barrier(0); }
    }
    float sm = 0.f;
#pragma unroll
    for (int n = 0; n < 16; ++n) sm += hsum4(acc[n]);
    sm += __shfl_xor(sm, 16); sm += __shfl_xor(sm, 32); const float mean = sm * (1.0f / 256.0f);
    float sq = 0.f;
#pragma unroll
    for (int n = 0; n < 16; ++n) { acc[n] = acc[n] - mean; sq += dot4(acc[n], acc[n]); }
    sq += __shfl_xor(sq, 16); sq += __shfl_xor(sq, 32); const float rs = 1.0f / sqrtf(sq * (1.0f / 256.0f) + EPS);
    const bf16_t* zr = F.Z + (r0 + i) * LDZ + ZC_RG + h * 256; bf16_t* br = F.BACT + (r0 + i) * RW + h * 256;
#pragma unroll
    for (int n = 0; n < 16; ++n) { const int dv = 16 * n + 4 * fq; const f32x4 gr = *(const f32x4*)(F.g_ret + h * 256 + dv), rg = unpk4(*(const u32x2*)(zr + dv));
        *(u32x2*)(br + dv) = pack4(acc[n] * rs * gr * rg); }
}
__device__ __forceinline__ void xattn_unit(const Frame& F, int b, int mh, int qb) {
    LAS unsigned char* img = F.lds; const int w = F.wave, tid = launder(F.tid), lane = tid & 63, fr = lane & 15, fq = lane >> 4;
    LAS unsigned char* Pw = F.lds + w * 8448; LAS unsigned char* imgV = F.lds + 67584;
    const size_t r0 = (size_t)b * 2048 + qb * 128; const int i = 16 * w + fr;
    bf16x8 qf[8];
#pragma unroll
    for (int s = 0; s < 8; ++s) qf[s] = *(const bf16x8*)(F.Z + (r0 + i) * LDZ + ZC_CQ + mh * 256 + 32 * s + 8 * fq);
    __syncthreads();
    stage_tile256<256>(img, F.MKV + (size_t)(b * 256) * 2048 + mh * 256, 2048, tid);
    __syncthreads();
    f32x4 acc[16];
#pragma unroll
    for (int n = 0; n < 16; ++n) { acc[n] = (f32x4){0.f, 0.f, 0.f, 0.f};
#pragma unroll
        for (int s = 0; s < 8; ++s) acc[n] = mma(acc[n], *(const LAS bf16x8*)(img + (16 * n + fr) * IMG_PITCH + (32 * s + 8 * fq) * 2), qf[s]); __builtin_amdgcn_sched_barrier(0); }
    float mx = -3.0e38f;
#pragma unroll
    for (int n = 0; n < 16; ++n) mx = fmaxf(mx, fmaxf(fmaxf(acc[n][0], acc[n][1]), fmaxf(acc[n][2], acc[n][3])));
    mx = fmaxf(mx, __shfl_xor(mx, 16)); mx = fmaxf(mx, __shfl_xor(mx, 32));
    float sm = 0.f;
#pragma unroll
    for (int n = 0; n < 16; ++n) {
#pragma unroll
        for (int e = 0; e < 4; ++e) acc[n][e] = ex2((acc[n][e] - mx) * 1.4426950408889634f);
        sm += hsum4(acc[n]); }
    sm += __shfl_xor(sm, 16); sm += __shfl_xor(sm, 32); const float inv = 1.0f / sm;
    __syncthreads();
#pragma unroll
    for (int n = 0; n < 16; ++n) { *(LAS u32x2*)(Pw + fr * IMG_PITCH + (16 * n + 4 * fq) * 2) = pack4(acc[n]); acc[n] = (f32x4){0.f, 0.f, 0.f, 0.f}; }
#pragma unroll
    for (int hf = 0; hf < 2; ++hf) {
        stage_tile256<128>(imgV, F.MKV + (size_t)(b * 256 + hf * 128) * 2048 + 1024 + mh * 256, 2048, tid);
        __syncthreads();
#pragma unroll
        for (int s = 0; s < 4; ++s) { const bf16x8 pf = *(const LAS bf16x8*)(Pw + fr * IMG_PITCH + (hf * 128 + 32 * s + 8 * fq) * 2);
#pragma unroll
            for (int n = 0; n < 16; ++n) { acc[n] = mma(acc[n], tr_frag(imgV, IMG_PITCH, 32 * s, 16 * n, lane), pf); if ((n & 3) == 3) __builtin_amdgcn_sched_barrier(0); } }
        __syncthreads();
    }
    const bf16_t* zr = F.Z + (r0 + i) * LDZ + ZC_CG + mh * 256; bf16_t* cr = F.CACT + (r0 + i) * MW + mh * 256;
#pragma unroll
    for (int n = 0; n < 16; ++n) { const int dv = 16 * n + 4 * fq; *(u32x2*)(cr + dv) = pack4(acc[n] * inv * unpk4(*(const u32x2*)(zr + dv))); }
}

template <int K>
__device__ __forceinline__ f32x4 skinny_dot(const bf16_t* arow, const bf16_t* brow) {
    f32x4 a0 = (f32x4){0.f, 0.f, 0.f, 0.f}, a1 = a0, a2 = a0, a3 = a0;
#pragma unroll 2
    for (int s = 0; s < K / 32; s += 8) {
        bf16x8 fa[8], fb[8];
#pragma unroll
        for (int j = 0; j < 8; ++j) { fa[j] = *(const bf16x8*)(arow + 32 * (s + j)); fb[j] = *(const bf16x8*)(brow + 32 * (s + j)); }
        a0 = mma(a0, fb[0], fa[0]); a1 = mma(a1, fb[1], fa[1]); a2 = mma(a2, fb[2], fa[2]); a3 = mma(a3, fb[3], fa[3]);
        a0 = mma(a0, fb[4], fa[4]); a1 = mma(a1, fb[5], fa[5]); a2 = mma(a2, fb[6], fa[6]); a3 = mma(a3, fb[7], fa[7]);
    }
    return (a0 + a1) + (a2 + a3);
}

struct Args { const float* in[19]; float* out; unsigned char* ws; int ph_lo, ph_hi; };
__global__ void __launch_bounds__(512, 2) mega_fwd(Args args) {
    extern __shared__ __attribute__((aligned(16))) unsigned char lds[];
    Frame F;
    F.lds = (LAS unsigned char*)lds;
    volatile LAS unsigned* MISC = (volatile LAS unsigned*)(F.lds + MISC_OFF);
    F.tid = threadIdx.x; F.lane = F.tid & 63; F.wave = __builtin_amdgcn_readfirstlane(F.tid >> 6); F.G = gridDim.x; F.cu = blockIdx.x;
    F.xp = args.in[0]; F.xs = args.in[1]; F.state = args.in[2]; F.cmk = args.in[3]; F.cmv = args.in[4]; F.memp = args.in[5]; F.g_pre = args.in[6]; F.w_in = args.in[7]; F.g_anorm = args.in[8];
    F.w_s = args.in[9]; F.b_s = args.in[10]; F.g_ret = args.in[11]; F.g_mem = args.in[12]; F.w_mem = args.in[13]; F.w_oa = args.in[14]; F.w_ob = args.in[15]; F.w_oc = args.in[16]; F.w_out = args.in[17]; F.g_final = args.in[18];
    F.out = args.out; F.ws = args.ws; unsigned char* ws = args.ws;
    F.WinT = (bf16_t*)(ws + WS_WIN); F.WmemT = (bf16_t*)(ws + WS_WMEM); F.WoaT = (bf16_t*)(ws + WS_WOA); F.WobT = (bf16_t*)(ws + WS_WOB); F.WocT = (bf16_t*)(ws + WS_WOC); F.WoutT = (bf16_t*)(ws + WS_WOUT);
    F.H = (bf16_t*)(ws + WS_H); F.MEMN = (bf16_t*)(ws + WS_MEMN); F.Z = (bf16_t*)(ws + WS_Z); F.MKV = (bf16_t*)(ws + WS_MKV); F.RS = (bf16_t*)(ws + WS_RS);
    F.AACT = (bf16_t*)(ws + WS_AACT); F.BACT = (bf16_t*)(ws + WS_BACT); F.CACT = (bf16_t*)(ws + WS_CACT); F.MG = (bf16_t*)(ws + WS_MG);
    F.ropec = (float*)(ws + WS_ROPE); F.ropes = F.ropec + 2049 * 128; F.statv = (float*)(ws + WS_STATV); F.stato = (float*)(ws + WS_STATO); F.stats = (float*)(ws + WS_STATS); F.SH = (float*)(ws + WS_SH); F.SW = (float*)(ws + WS_SW); F.CMAX = (unsigned*)(ws + WS_CMAX); F.H8 = ws + WS_H8; F.W8 = ws + WS_W8; F.A8 = ws + WS_A8; F.B8 = ws + WS_B8; F.C8 = ws + WS_C8; F.M8 = ws + WS_M8; F.W8a = ws + WS_W8A; F.W8b = ws + WS_W8B; F.W8c = ws + WS_W8C; F.W8o = ws + WS_W8O;
    F.sA = (float*)(ws + WS_SX); F.sB = F.sA + 8192; F.sC = F.sB + 8192; F.sM = F.sC + 8192; F.SWa = F.sM + 8192; F.SWb = F.SWa + 4096; F.SWc = F.SWb + 4096; F.SWo = F.SWc + 4096;
    for (int u = F.tid; u < (LDS_BYTES - MISC_OFF) / 4; u += 512) ((LAS unsigned*)(F.lds + MISC_OFF))[u] = 0u;
    __syncthreads();
    XcdBarrier bar; bar.bar = (unsigned*)(ws + WS_CTL) + CW_BAR; bar.x = 0; bar.st = nullptr;
    if (MK_N_LAUNCHES == 1) bar = xcd_barrier_post((unsigned*)(ws + WS_CTL) + CW_BAR, MISC + 8);
    const int lo = args.ph_lo, hi = args.ph_hi;
#ifndef PHASE_MASK
#define PHASE_MASK 0x3ff
#endif
#define IN(k) (((PHASE_MASK >> (k)) & 1) && lo <= (k) && (k) < hi)
#define SEAM(k) do { if (IN(k) && IN((k) + 1)) xcd_barrier(bar); } while (0)
#ifndef REPEAT_PHASE
#define REPEAT_PHASE (-1)
#endif
#define REP(k) for (int rp_ = 0; rp_ < ((REPEAT_PHASE == (k)) ? 2 : 1); ++rp_, (void)((REPEAT_PHASE == (k) && rp_ == 1) ? (xcd_barrier(bar), 0) : 0))

    if (IN(0)) REP(0) { p0a_prologue(F); }
    SEAM(0);
    if (IN(1)) REP(1) {
        const int NGC = F.G >= 64 ? 32 : 0;
        if (NGC == 0 || F.cu < NGC) { pg8::Order S; S.init(F.MEMN, F.WmemT, 1024, 2048, NGC ? NGC : F.G, F.cu);
            EpiMem E{F.out + O_MK, F.out + O_MV, F.MKV};
            pg8::gemm_phase<EpiMem, pg8::Order, true>(F.lds, D, S, E); }
        if (NGC == 0 || F.cu >= NGC) { LAS float* scr = (LAS float*)(F.lds + F.wave * 8448);
            for (int it = (F.cu - NGC) * 8 + F.wave; it < 64 * 768; it += (F.G - NGC) * 8) p0_quant_item(F, scr, it, F.lane);
            for (int it = (F.cu - NGC) * 8 + F.wave; it < 4 * 4096; it += (F.G - NGC) * 8) { const int n = it & 4095;
                if (it < 4096) quant_row<AW>(F.WoaT + (size_t)n * AW, F.W8a, perm_slot(n), F.SWa + n, F.lane);
                else if (it < 8192) quant_row<RW>(F.WobT + (size_t)n * RW, F.W8b, perm_slot(n), F.SWb + n, F.lane);
                else if (it < 12288) quant_row<MW>(F.WocT + (size_t)n * MW, F.W8c, perm_slot(n), F.SWc + n, F.lane);
                else quant_row<D>(F.WoutT + (size_t)n * D, F.W8o, n, F.SWo + n, F.lane); } }
    }
    SEAM(1);
    if (IN(2)) REP(2) {
        { pg8::OrderP1 S{F.H, F.WinT, F.G, F.cu, 0}; EpiZ<false> E{F.Z, F.statv, F.ropec, F.ropes, F.SH, F.SW};
          pg8::gemm_phase<EpiZ<false>, pg8::OrderP1, true, false>(F.lds, D, S, E); }
        { pg8::OrderP1 S{F.H8, F.W8, F.G, F.cu, 1}; EpiZ<true> E{F.Z, F.statv, F.ropec, F.ropes, F.SH, F.SW};
          pg8::gemm_phase<EpiZ<true>, pg8::OrderP1, true, true>(F.lds, D, S, E); }
    }
    SEAM(2);
    if (IN(3)) REP(3) {
#ifndef REPEAT_SUB
#define REPEAT_SUB 0
#endif
        for (int rs_ = 0; rs_ < (REPEAT_SUB == 1 ? 2 : 1); ++rs_) for (int u = F.cu; u < 256; u += F.G) scan_unit(F, u >> 6, (u >> 3) & 7, u & 7);
        for (int rs_ = 0; rs_ < (REPEAT_SUB == 2 ? 2 : 1); ++rs_) for (int u = F.cu; u < 512; u += F.G) spatial_unit(F, u >> 7, (u >> 3) & 15, (u >> 1) & 3, u & 1);
        for (int s = F.cu * 8 + F.wave; s < MS; s += F.G * 8) spatial_sample_row(F, s);
        for (int rs_ = 0; rs_ < (REPEAT_SUB == 3 ? 2 : 1); ++rs_) for (int u = F.cu; u < 1024; u += F.G) ret_sample_item(F, u >> 3, u & 7);
        for (int rs_ = 0; rs_ < (REPEAT_SUB == 4 ? 2 : 1); ++rs_) for (int u = F.cu; u < 512; u += F.G) xattn_sample_item(F, u >> 2, u & 3);
#ifdef DIAG_ZERO_Y
        for (size_t i = (size_t)F.cu * 512 + F.tid; i < (O_RP / 4); i += (size_t)F.G * 512) ((f32x4*)F.out)[i] = (f32x4){0.f, 0.f, 0.f, 0.f};
#endif
    }
    SEAM(3);
    if (IN(4)) REP(4) {
        for (int u = F.cu; u < 512; u += F.G) ret_out_unit(F, u >> 7, (u >> 4) & 7, u & 15);
        for (int u = F.cu; u < 256; u += F.G) xattn_unit(F, u >> 6, (u >> 4) & 3, u & 15);
        __syncthreads();
    }
    SEAM(4);
    if (IN(5)) {
        for (int it = F.cu * 8 + F.wave; it < 3 * MP; it += F.G * 8) { const int m = it % MP;
            if (it < MP) quant_row<AW>(F.AACT + (size_t)m * AW, F.A8, m, F.sA + m, F.lane);
            else if (it < 2 * MP) quant_row<RW>(F.BACT + (size_t)m * RW, F.B8, m, F.sB + m, F.lane);
            else quant_row<MW>(F.CACT + (size_t)m * MW, F.C8, m, F.sC + m, F.lane); }
        { const int w = F.wave, fr = F.lane & 15, fq = F.lane >> 4; const size_t row = (size_t)MP + 16 * w + fr;
          for (int nt = F.cu; nt < 256; nt += F.G) { const int n0 = 16 * nt;
              const f32x4 ya = skinny_dot<AW>(F.AACT + row * AW + 8 * fq, F.WoaT + (size_t)(n0 + fr) * AW + 8 * fq);
              const f32x4 yb = skinny_dot<RW>(F.BACT + row * RW + 8 * fq, F.WobT + (size_t)(n0 + fr) * RW + 8 * fq);
              const f32x4 yc = skinny_dot<MW>(F.CACT + row * MW + 8 * fq, F.WocT + (size_t)(n0 + fr) * MW + 8 * fq);
              const bf16_t* gz = F.Z + row * LDZ + ZC_GS + n0 + 4 * fq;
              const f32x4 g0 = unpk4(*(const u32x2*)gz), g1 = unpk4(*(const u32x2*)(gz + D)), g2 = unpk4(*(const u32x2*)(gz + 2 * D));
              *(u32x2*)(F.MG + row * D + n0 + 4 * fq) = pack4(g0 * ya + g1 * yb + g2 * yc); } }
    }
    SEAM(5);
    if (IN(6)) {
        for (int pass = 0; pass < 3; ++pass) {
            const unsigned char* A = pass == 0 ? F.A8 : (pass == 1 ? F.B8 : F.C8); const unsigned char* Bt = pass == 0 ? F.W8a : (pass == 1 ? F.W8b : F.W8c); const int K = pass == 2 ? MW : AW;
            pg8::Order S; S.init((const bf16_t*)A, (const bf16_t*)Bt, MP, D, F.G, F.cu);
            EpiMerge8 E{F.Z, F.MG, pass == 0 ? F.sA : (pass == 1 ? F.sB : F.sC), pass == 0 ? F.SWa : (pass == 1 ? F.SWb : F.SWc), pass};
            pg8::gemm_phase<EpiMerge8, pg8::Order, true, true>(F.lds, K, S, E);
        }
    }
    SEAM(6);
    if (IN(7)) {
        for (int m = F.cu * 8 + F.wave; m < MP; m += F.G * 8) quant_row<D>(F.MG + (size_t)m * D, F.M8, m, F.sM + m, F.lane);
        { const int w = F.wave, fr = F.lane & 15, fq = F.lane >> 4; const int r = 16 * w + fr; const size_t row = (size_t)MP + r;
          for (int nt = F.cu; nt < 256; nt += F.G) { const int n0 = 16 * nt;
              const f32x4 y = skinny_dot<D>(F.MG + row * D + 8 * fq, F.WoutT + (size_t)(n0 + fr) * D + 8 * fq);
              const f32x4 v = *(const f32x4*)(F.xs + (size_t)r * D + n0 + 4 * fq) + y;
              *(f32x4*)(F.out + O_YS + (size_t)r * D + n0 + 4 * fq) = v;
              float q = dot4(v, v); q += __shfl_xor(q, 16); q += __shfl_xor(q, 32);
              if (fq == 0) F.stats[r * 256 + nt] = q; } }
    }
    SEAM(7);
    if (IN(8)) {
        pg8::Order S; S.init((const bf16_t*)F.M8, (const bf16_t*)F.W8o, MP, D, F.G, F.cu);
        EpiOut8 E{F.xp, F.out + O_YP, F.stato, F.sM, F.SWo};
        pg8::gemm_phase<EpiOut8, pg8::Order, true, true>(F.lds, D, S, E);
    }
    SEAM(8);
    if (IN(9)) {
        const int lane = F.lane;
        for (int m = F.cu * 8 + F.wave; m < MREAL; m += F.G * 8) {
            float q; float* yr;
            if (m < MP) { q = wave_sum(F.stato[(size_t)m * 64 + lane]); yr = F.out + O_YP + (size_t)m * D; }
            else { const float* sp = F.stats + (size_t)(m - MP) * 256; q = wave_sum((sp[lane] + sp[lane + 64]) + (sp[lane + 128] + sp[lane + 192])); yr = F.out + O_YS + (size_t)(m - MP) * D; }
            const float r = 1.0f / sqrtf(q * (1.0f / 4096.0f) + EPS);
            f32x4* y4 = (f32x4*)yr + lane; const f32x4* g4 = (const f32x4*)F.g_final + lane;
            f32x4 v[16];
#pragma unroll
            for (int j = 0; j < 16; ++j) v[j] = y4[64 * j];
#pragma unroll
            for (int j = 0; j < 16; ++j) y4[64 * j] = v[j] * r * g4[64 * j];
        }
    }
#undef IN
#undef SEAM
}


__global__ void diag_hash(const unsigned char* ws, unsigned long long* table) {
    const unsigned* Z = (const unsigned*)(ws + WS_Z);
    const int segs[6] = {12288, 14336, 15360, 16384, 20480, 24576}; const int wid[6] = {2048, 1024, 1024, 4096, 4096, 4096};
    for (int r = 0; r < 6; ++r) { const int c0 = segs[r] / 2, nc = wid[r] / 2; unsigned long long h = 0;
        for (size_t i = (size_t)blockIdx.x * blockDim.x + threadIdx.x; i < (size_t)MPAD * nc; i += (size_t)gridDim.x * blockDim.x) { const size_t row = i / nc, c = i % nc; h += (unsigned long long)Z[row * (LDZ / 2) + c0 + c] * (unsigned long long)(i * 2654435761ull + 12345ull); }
        for (int o = 32; o >= 1; o >>= 1) h += __shfl_xor(h, o);
        if ((threadIdx.x & 63) == 0) atomicAdd(table + r, h); }
}
__global__ void diag_finish(float* out, const unsigned long long* t0, const unsigned long long* t1) {
    int mask = 0; for (int r = 0; r < 6; ++r) if (t0[r] != t1[r]) mask |= 1 << r;
    for (size_t i = (size_t)blockIdx.x * blockDim.x + threadIdx.x; i < O_END; i += (size_t)gridDim.x * blockDim.x) out[i] = (i == 0) ? __uint_as_float((unsigned)(127 + 10 + mask) << 23) : 0.f;
}
extern "C" void kernel_launch(void* const* d_in, const int* in_sizes, int n_in, void* d_out, int out_size, void* d_ws, size_t ws_size, hipStream_t stream) {
    static int grid = 0;
    if (grid == 0) {
        if (n_in != 19 || out_size != (int)O_END || ws_size < WS_END) { fprintf(stderr, "kernel_launch: unexpected problem shape (n_in %d, out %d, ws %zu); nothing launched\n", n_in, out_size, ws_size); grid = -1; return; }
        int dev = 0, cus = 0, per_cu = 0;
        if (hipGetDevice(&dev) != hipSuccess || hipDeviceGetAttribute(&cus, hipDeviceAttributeMultiprocessorCount, dev) != hipSuccess) { grid = -1; return; }
        if (hipFuncSetAttribute((const void*)mega_fwd, hipFuncAttributeMaxDynamicSharedMemorySize, LDS_BYTES) != hipSuccess) { fprintf(stderr, "kernel_launch: hipFuncSetAttribute failed\n"); grid = -1; return; }
        if (hipOccupancyMaxActiveBlocksPerMultiprocessor(&per_cu, (const void*)mega_fwd, 512, LDS_BYTES) != hipSuccess || per_cu < 1) fprintf(stderr, "kernel_launch: occupancy query says %d blocks per CU\n", per_cu);
        (void)hipGetLastError();
        grid = cus;
    }
    if (grid < 0) return;
    (void)hipMemsetAsync((char*)d_ws + WS_CTL, 0, CTL_ZERO_BYTES, stream);
    Args a{};
    for (int i = 0; i < 19; ++i) a.in[i] = (const float*)d_in[i];
    a.out = (float*)d_out; a.ws = (unsigned char*)d_ws;
#ifdef DIAG_DET
    for (int rep = 0; rep < 2; ++rep) { a.ph_lo = 0; a.ph_hi = 2; if (rep) (void)hipMemsetAsync((char*)d_ws + WS_CTL, 0, 32 * 1024, stream);
        hipLaunchKernelGGL(mega_fwd, dim3(grid), dim3(512), LDS_BYTES, stream, a);
        hipLaunchKernelGGL(diag_hash, dim3(1024), dim3(256), 0, stream, (const unsigned char*)d_ws, (unsigned long long*)((char*)d_ws + 32 * 1024 + rep * 1024)); }
    hipLaunchKernelGGL(diag_finish, dim3(1024), dim3(256), 0, stream, (float*)d_out, (const unsigned long long*)((char*)d_ws + 32 * 1024), (const unsigned long long*)((char*)d_ws + 33 * 1024));
    return;
#endif
    if (MK_N_LAUNCHES == 1) { a.ph_lo = 0; a.ph_hi = 10; hipLaunchKernelGGL(mega_fwd, dim3(grid), dim3(512), LDS_BYTES, stream, a); }
    else { for (int p = 0; p < 10; ++p) { a.ph_lo = p; a.ph_hi = p + 1; hipLaunchKernelGGL(mega_fwd, dim3(grid), dim3(512), LDS_BYTES, stream, a); } }
}
```

```cpp
#include <hip/hip_runtime.h>
#include <cstdio>
#include <cstdint>

#ifndef MK_N_LAUNCHES
#define MK_N_LAUNCHES 1
#endif

#define LAS __attribute__((address_space(3)))
#define GAS __attribute__((address_space(1)))
typedef unsigned short bf16_t;
typedef short bf16x8 __attribute__((ext_vector_type(8)));
typedef short s16x4 __attribute__((ext_vector_type(4)));
typedef float f32x4 __attribute__((ext_vector_type(4)));
typedef float f32x2 __attribute__((ext_vector_type(2)));
typedef unsigned u32x4 __attribute__((ext_vector_type(4)));
typedef unsigned u32x2 __attribute__((ext_vector_type(2)));
typedef int i32x4 __attribute__((ext_vector_type(4)));
typedef GAS unsigned gu32;

constexpr int D = 4096, MP = 8192, MS = 128, MREAL = MP + MS, MPAD = 8448;
constexpr int NIN = 28672, LDZ = NIN, AW = 2048, RW = 2048, MW = 1024;
constexpr int ZC_U = 0, ZC_V = 2048, ZC_G = 4096, ZC_Q = 6144, ZC_K = 8192, ZC_RV = 10240, ZC_RG = 12288, ZC_CQ = 14336, ZC_CG = 15360, ZC_GS = 16384;
constexpr float EPS = 1e-6f;
constexpr size_t O_YP = 0, O_YS = 33554432, O_RP = 34078720, O_MK = 36175872, O_MV = 37224448, O_RS = 38273024, O_GV = 105381888, O_END = 105644032;

constexpr size_t MiB = 1u << 20;
constexpr size_t WS_CTL = 0, CTL_ZERO_BYTES = 256 * 1024;
constexpr size_t WS_CMAX = 128 * 1024;
constexpr size_t WS_ROPE = 1 * MiB;
constexpr size_t WS_STATV = 4 * MiB;
constexpr size_t WS_STATO = 7 * MiB;
constexpr size_t WS_STATS = 10 * MiB;
constexpr size_t WS_WIN = 16 * MiB;
constexpr size_t WS_WMEM = 240 * MiB;
constexpr size_t WS_WOA = 256 * MiB;
constexpr size_t WS_WOB = 272 * MiB;
constexpr size_t WS_WOC = 288 * MiB;
constexpr size_t WS_WOUT = 296 * MiB;
constexpr size_t WS_H = 328 * MiB;
constexpr size_t WS_MEMN = 394 * MiB;
constexpr size_t WS_Z = 402 * MiB;
constexpr size_t WS_MKV = 864 * MiB;
constexpr size_t WS_RS = 868 * MiB;
constexpr size_t WS_AACT = 928 * MiB;
constexpr size_t WS_BACT = 961 * MiB;
constexpr size_t WS_CACT = 994 * MiB;
constexpr size_t WS_MG = 1012 * MiB;
constexpr size_t WS_H8 = 1100 * MiB;
constexpr size_t WS_W8 = 1136 * MiB;
constexpr size_t WS_SH = 12 * MiB;
constexpr size_t WS_SW = 13 * MiB;
constexpr size_t WS_A8 = 1232 * MiB, WS_B8 = 1248 * MiB, WS_C8 = 1264 * MiB, WS_M8 = 1272 * MiB;
constexpr size_t WS_W8A = 1304 * MiB, WS_W8B = 1312 * MiB, WS_W8C = 1320 * MiB, WS_W8O = 1324 * MiB;
constexpr size_t WS_SX = 14 * MiB;
constexpr size_t WS_END = 1340 * MiB;
static_assert(WS_WIN + (size_t)NIN * D * 2 <= WS_WMEM && WS_H + (size_t)MPAD * D * 2 <= WS_MEMN && WS_Z + (size_t)MPAD * LDZ * 2 <= WS_MKV, "ws map");
static_assert(WS_RS + (size_t)480 * 65536 * 2 <= WS_AACT && WS_AACT + (size_t)MPAD * AW * 2 <= WS_BACT && WS_CACT + (size_t)MPAD * MW * 2 <= WS_MG && WS_MG + (size_t)MPAD * D * 2 <= WS_END, "ws map 2");
constexpr int CW_BAR = 1024;
constexpr int CW_Q = 512;

constexpr int RING_BYTES = 131072;
constexpr int IMG_PITCH = 528;
constexpr int SMALL_OFF = 135168;
constexpr int MISC_OFF = 151552;
constexpr int LDS_BYTES = 155648;

#define LDS_WAIT() asm volatile("s_waitcnt lgkmcnt(0)" ::: "memory")
#define VM_WAIT() asm volatile("s_waitcnt vmcnt(0)" ::: "memory")

namespace pg8 {
constexpr int BM = 256, BK = 64, HALF = 128, HTB = HALF * BK * 2, STAGE_BYTES = 8 * HTB, NXCD = 8, WGM = 8;
__host__ __device__ __forceinline__ int lds_byte(int r, int c) { const int st = (r >> 4) * 2 + (c >> 5), rr = r & 15, cc = c & 31, ob = rr * 64 + cc * 2; return st * 1024 + (ob ^ (((ob >> 9) & 1) << 5)); }
__host__ __device__ __forceinline__ void stage_rc(int b, int& R, int& C) { const int st = b / 1024, sb = b % 1024, swz = sb ^ (((sb >> 9) & 1) << 5); R = (st >> 1) * 16 + swz / 64; C = (st & 1) * 32 + (swz % 64) / 2; }
__host__ __device__ __forceinline__ int perm32(int rho) { const int n = rho >> 4, i = rho & 15; return 8 * (i >> 2) + 4 * n + (i & 3); }

struct Unit { int pm, pn, kind; };

struct Order {
    const bf16_t *A0, *B0, *A1, *B1; int nM, nN, nwg, nX, nXn, G, c;
    __device__ __forceinline__ void init(const bf16_t* a0, const bf16_t* b0, int M, int N, int G_, int c_) { A0 = a0; B0 = b0; A1 = a0; B1 = b0; nM = M / BM; nN = N / BM; nwg = nM * nN; nX = 0; nXn = 1; G = G_; c = c_; }
    __device__ __forceinline__ bool next(int i, Unit& u) const {
        const long L = (long)i * G + c; const bool ok = L < nwg + nX; const bool ex = L >= nwg;
        const int r = (int)L - nwg;
        int wgid = ex ? 0 : (int)L; { const int q = nwg / NXCD, rr = nwg % NXCD, xcd = wgid % NXCD, off = wgid / NXCD; wgid = (xcd < rr ? xcd * (q + 1) : rr * (q + 1) + (xcd - rr) * q) + off; }
        const int nig = WGM * nN, gid = wgid / nig, fm = gid * WGM, gsz = (nM - fm) < WGM ? (nM - fm) : WGM;
        const int pm0 = fm + ((wgid % nig) % gsz), pn0 = (wgid % nig) / gsz;
        const int pm = ex ? r / nXn : pm0, pn = ex ? r % nXn : pn0;
        u.pm = pm; u.pn = pn; u.kind = ex ? 1 : 0; return ok;
    }
    __device__ __forceinline__ void operands(const Unit& u, size_t tstep, const char*& a, const char*& b) const {
        a = (const char*)(u.kind ? A1 : A0) + (size_t)u.pm * tstep; b = (const char*)(u.kind ? B1 : B0) + (size_t)u.pn * tstep; }
};

struct OrderP1 {
    const void* A; const void* B; int G, c, i8;
    __device__ __forceinline__ bool next(int i, Unit& u) const {
        if (!i8) { const long L = (long)i * G + c; const bool ok = L < 536; const bool smp = L >= 512; const int t = (int)L - 512;
            int wgid = smp ? 0 : (int)L; wgid = (wgid % 8) * 64 + wgid / 8;
            const int pm0 = (wgid / 128) * 8 + ((wgid % 128) % 8), pn0 = 32 + (wgid % 128) / 8;
            u.pm = smp ? 32 : pm0; u.pn = smp ? (t < 8 ? 8 + t : 24 + t) : pn0; u.kind = 0; return ok; }
        long j = (long)i * G + c;
        if (G == 256) { j = 1 << 30; if (i < 11) j = c + 256 * i; else if (i == 11 && c >= 24) j = 2816 + (c - 24); else if (i == 12 && c >= 24 && c < 144) j = 3048 + (c - 24); }
        const bool ok = j < 3168;
        int wgid = ok ? (int)j : 0; wgid = (wgid % 8) * 396 + wgid / 8;
        const int gid = wgid / 768, fm = gid * 8, gsz = (33 - fm) < 8 ? (33 - fm) : 8;
        u.pm = fm + ((wgid % 768) % gsz); u.pn = (wgid % 768) / gsz; u.kind = 0; return ok;
    }
    __device__ __forceinline__ void operands(const Unit& u, size_t tstep, const char*& a, const char*& b) const { a = (const char*)A + (size_t)u.pm * tstep; b = (const char*)B + (size_t)u.pn * tstep; }
};

typedef float cvf32x2_t __attribute__((ext_vector_type(2))); typedef __bf16 cvbf16x2_t __attribute__((ext_vector_type(2)));
__device__ __forceinline__ unsigned cvt_pk_bf16(float lo, float hi) { cvf32x2_t v = {lo, hi}; cvbf16x2_t b = __builtin_convertvector(v, cvbf16x2_t); return __builtin_bit_cast(unsigned, b); }

template <class Epi, class Sched, bool IMG = false, bool I8 = false, bool ALIGN_EPI = true, bool SP2 = true>
__device__ __forceinline__ void gemm_phase(LAS unsigned char* lds, const int K, const Sched& S, const Epi& E) {
    const int tid = threadIdx.x, wid = __builtin_amdgcn_readfirstlane(tid >> 6), lane = tid & 63, wr = wid >> 2, wc = wid & 3, fr = lane & 15, fq = lane >> 4;
    const int nt = I8 ? K / 128 : K / BK;
    unsigned voffA[2], voffB[2];
#pragma unroll
    for (int i = 0; i < 2; ++i) { int R, C; stage_rc(tid * 16 + i * 8192, R, C); const int Rb = Epi::PERM ? ((R & ~31) + perm32(R & 31)) : R;
        voffA[i] = (unsigned)(R * K + C) * 2u; voffB[i] = (unsigned)(Rb * K + C) * 2u;
        if (IMG) { voffA[i] = (unsigned)(tid * 16 + i * 8192); voffB[i] = voffA[i]; } }
    const size_t kstep = IMG ? (size_t)HTB : (size_t)(BK * 2);
    const size_t hstep = (size_t)HALF * K * (I8 ? 1 : 2);
    const size_t tstep = 2 * hstep;
    const unsigned ldsw = (unsigned)wid * 1024u;
    const int aoff = lds_byte(wr * 64 + fr, fq * 8), boff = lds_byte(wc * 32 + fr, fq * 8);
#define PG8_SA(b, h) (((b) * 2 + (h)) * HTB)
#define PG8_SB(b, h) ((4 + (b) * 2 + (h)) * HTB)
#define PG8_STAGE(bufoff, gbase, voff) do { _Pragma("unroll") for (int _i = 0; _i < 2; ++_i) \
        __builtin_amdgcn_global_load_lds((const unsigned*)((const char*)(gbase) + (voff)[_i]), (LAS unsigned*)(lds + (bufoff) + ldsw + _i * 8192), 16, 0, 0); } while (0)
#define PG8_LDA(dst, b, h) do { _Pragma("unroll") for (int m = 0; m < 4; ++m) _Pragma("unroll") for (int k = 0; k < 2; ++k) dst[m][k] = *(const LAS bf16x8*)(lds + PG8_SA(b, h) + aoff + m * 2048 + k * 1024); } while (0)
#define PG8_LDB(dst, b, h) do { _Pragma("unroll") for (int n = 0; n < 2; ++n) _Pragma("unroll") for (int k = 0; k < 2; ++k) dst[n][k] = *(const LAS bf16x8*)(lds + PG8_SB(b, h) + boff + n * 2048 + k * 1024); } while (0)
#define PG8_MMA(ai, bj, At, Bt) do { __builtin_amdgcn_s_setprio(1); _Pragma("unroll") for (int m = 0; m < 4; ++m) _Pragma("unroll") for (int n = 0; n < 2; ++n) _Pragma("unroll") for (int k = 0; k < 2; ++k) \
        { if constexpr (I8) acc[ai][bj][m][n] = __builtin_bit_cast(f32x4, __builtin_amdgcn_mfma_i32_16x16x64_i8(__builtin_bit_cast(i32x4, Bt[n][k]), __builtin_bit_cast(i32x4, At[m][k]), __builtin_bit_cast(i32x4, acc[ai][bj][m][n]), 0, 0, 0)); \
          else acc[ai][bj][m][n] = __builtin_amdgcn_mfma_f32_16x16x32_bf16(Bt[n][k], At[m][k], acc[ai][bj][m][n], 0, 0, 0); } __builtin_amdgcn_s_setprio(0); } while (0)
#define PG8_WAIT_V(n) asm volatile("s_waitcnt vmcnt(" #n ")" ::: "memory")
#define PG8_WAIT_L(n) asm volatile("s_waitcnt lgkmcnt(" #n ")" ::: "memory")
#define PG8_BAR __builtin_amdgcn_s_barrier()
#define PG8_SCHED __builtin_amdgcn_sched_barrier(0)
    Unit cur, nxt; int ui = 0;
    if (!S.next(0, cur)) return;
    f32x4 acc[2][2][4][2];
#pragma unroll
    for (int a = 0; a < 2; ++a)
#pragma unroll
        for (int b = 0; b < 2; ++b)
#pragma unroll
            for (int m = 0; m < 4; ++m)
#pragma unroll
                for (int n = 0; n < 2; ++n) acc[a][b][m][n] = (f32x4){0.f, 0.f, 0.f, 0.f};
    bf16x8 At[4][2], B0[2][2], B1[2][2];
    const char* cA; const char* cB; S.operands(cur, tstep, cA, cB);
    if constexpr (SP2) {
        PG8_STAGE(PG8_SB(0, 0), cB, voffB); PG8_STAGE(PG8_SB(0, 1), cB + hstep, voffB); PG8_STAGE(PG8_SA(0, 0), cA, voffA); PG8_STAGE(PG8_SA(0, 1), cA + hstep, voffA);
        if (wr == 1) PG8_BAR;
        PG8_WAIT_V(2); PG8_BAR;
        PG8_STAGE(PG8_SB(1, 0), cB + kstep, voffB); PG8_STAGE(PG8_SA(1, 0), cA + kstep, voffA); PG8_STAGE(PG8_SB(1, 1), cB + hstep + kstep, voffB);
        PG8_WAIT_V(6); PG8_BAR;
    } else {
        PG8_STAGE(PG8_SB(0, 0), cB, voffB); PG8_STAGE(PG8_SA(0, 0), cA, voffA); PG8_STAGE(PG8_SB(0, 1), cB + hstep, voffB); PG8_STAGE(PG8_SA(0, 1), cA + hstep, voffA);
        if (wr == 1) PG8_BAR;
        PG8_WAIT_V(4); PG8_BAR;
        PG8_STAGE(PG8_SB(1, 0), cB + kstep, voffB); PG8_STAGE(PG8_SA(1, 0), cA + kstep, voffA); PG8_STAGE(PG8_SB(1, 1), cB + hstep + kstep, voffB);
        PG8_WAIT_V(6); PG8_BAR;
    }
    for (;;) {
        const bool has_next = S.next(ui + 1, nxt);
        const char* nA = cA; const char* nB = cB; if (has_next) S.operands(nxt, tstep, nA, nB);
        for (int t = 0; t < nt; t += 2) {
            const bool last = (t == nt - 2);
            const char* a1 = cA + (size_t)(t + 1) * kstep;
            const char* a2 = last ? nA : cA + (size_t)(t + 2) * kstep; const char* b2 = last ? nB : cB + (size_t)(t + 2) * kstep;
            const char* a3 = a2 + kstep; const char* b3 = b2 + kstep;
            if constexpr (SP2) {
            PG8_LDB(B0, 0, 0); PG8_LDB(B1, 0, 1); PG8_SCHED; PG8_LDA(At, 0, 0); PG8_STAGE(PG8_SA(1, 1), a1 + hstep, voffA);
            PG8_WAIT_V(8); PG8_WAIT_L(0); PG8_BAR; PG8_MMA(0, 0, At, B0); PG8_MMA(0, 1, At, B1); PG8_BAR; PG8_SCHED;
            PG8_LDA(At, 0, 1); PG8_STAGE(PG8_SB(0, 0), b2, voffB); PG8_STAGE(PG8_SB(0, 1), b2 + hstep, voffB); PG8_STAGE(PG8_SA(0, 0), a2, voffA);
            PG8_WAIT_V(8); PG8_WAIT_L(0); PG8_BAR; PG8_MMA(1, 0, At, B0); PG8_MMA(1, 1, At, B1); PG8_BAR; PG8_SCHED;
            PG8_LDB(B0, 1, 0); PG8_LDB(B1, 1, 1); PG8_SCHED; PG8_LDA(At, 1, 0); PG8_STAGE(PG8_SA(0, 1), a2 + hstep, voffA);
            PG8_WAIT_V(8); PG8_WAIT_L(0); PG8_BAR; PG8_MMA(0, 0, At, B0); PG8_MMA(0, 1, At, B1); PG8_BAR; PG8_SCHED;
            PG8_LDA(At, 1, 1); PG8_STAGE(PG8_SB(1, 0), b3, voffB); PG8_STAGE(PG8_SB(1, 1), b3 + hstep, voffB); PG8_STAGE(PG8_SA(1, 0), a3, voffA);
            PG8_WAIT_V(8); PG8_WAIT_L(0); PG8_BAR; PG8_MMA(1, 0, At, B0); PG8_MMA(1, 1, At, B1); PG8_BAR; PG8_SCHED;
            } else {
            PG8_LDB(B0, 0, 0); PG8_SCHED; PG8_LDA(At, 0, 0); PG8_STAGE(PG8_SA(1, 1), a1 + hstep, voffA);
            PG8_WAIT_L(8); PG8_BAR; PG8_WAIT_L(0); PG8_MMA(0, 0, At, B0); PG8_BAR; PG8_SCHED;
            PG8_LDB(B1, 0, 1); PG8_STAGE(PG8_SB(0, 0), b2, voffB);
            PG8_BAR; PG8_WAIT_L(0); PG8_MMA(0, 1, At, B1); PG8_BAR;
            PG8_LDA(At, 0, 1); PG8_STAGE(PG8_SA(0, 0), a2, voffA);
            PG8_BAR; PG8_WAIT_L(0); PG8_MMA(1, 0, At, B0); PG8_BAR; PG8_SCHED;
            PG8_STAGE(PG8_SB(0, 1), b2 + hstep, voffB);
            PG8_WAIT_V(6); PG8_BAR; PG8_MMA(1, 1, At, B1); PG8_BAR;
            PG8_LDB(B0, 1, 0); PG8_SCHED; PG8_LDA(At, 1, 0); PG8_STAGE(PG8_SA(0, 1), a2 + hstep, voffA);
            PG8_WAIT_L(8); PG8_BAR; PG8_WAIT_L(0); PG8_MMA(0, 0, At, B0); PG8_BAR; PG8_SCHED;
            PG8_LDB(B1, 1, 1); PG8_STAGE(PG8_SB(1, 0), b3, voffB);
            PG8_BAR; PG8_WAIT_L(0); PG8_MMA(0, 1, At, B1); PG8_BAR;
            PG8_LDA(At, 1, 1); PG8_STAGE(PG8_SA(1, 0), a3, voffA);
            PG8_BAR; PG8_WAIT_L(0); PG8_MMA(1, 0, At, B0); PG8_BAR; PG8_SCHED;
            PG8_STAGE(PG8_SB(1, 1), b3 + hstep, voffB);
            PG8_WAIT_V(6); PG8_BAR; PG8_MMA(1, 1, At, B1); PG8_BAR;
            }
        }
        if constexpr (ALIGN_EPI) { if (wr == 0) PG8_BAR; }
        E(acc, cur, wr, wc, fr, fq);
        if (!has_next) break;
#pragma unroll
        for (int a = 0; a < 2; ++a)
#pragma unroll
            for (int b = 0; b < 2; ++b)
#pragma unroll
                for (int m = 0; m < 4; ++m)
#pragma unroll
                    for (int n = 0; n < 2; ++n) acc[a][b][m][n] = (f32x4){0.f, 0.f, 0.f, 0.f};
        cur = nxt; cA = nA; cB = nB; ++ui;
        if constexpr (ALIGN_EPI) { if (wr == 1) PG8_BAR; }
    }
    PG8_WAIT_V(0);
    if constexpr (!ALIGN_EPI) { if (wr == 0) PG8_BAR; }
    PG8_BAR;
#undef PG8_SA
#undef PG8_SB
#undef PG8_STAGE
#undef PG8_LDA
#undef PG8_LDB
#undef PG8_MMA
#undef PG8_WAIT_V
#undef PG8_WAIT_L
#undef PG8_BAR
#undef PG8_SCHED
}
}


__device__ __forceinline__ size_t img_off(int row, int k, int K) { return ((size_t)(row >> 7) * (size_t)(K >> 6) + (size_t)(k >> 6)) * 16384u + (size_t)pg8::lds_byte(row & 127, k & 63); }
__device__ __forceinline__ size_t img8_off(int row, int k, int K) { return ((size_t)(row >> 7) * (size_t)(K >> 7) + (size_t)(k >> 7)) * 16384u + (size_t)pg8::lds_byte(row & 127, (k & 127) >> 1) + (size_t)(k & 1); }
__device__ __forceinline__ int perm_slot(int n) { const int s = n & 31; return (n & ~31) + 16 * ((s >> 2) & 1) + 4 * (s >> 3) + (s & 3); }
__device__ __forceinline__ unsigned pk2(float lo, float hi) { return pg8::cvt_pk_bf16(lo, hi); }
__device__ __forceinline__ float bflo(unsigned u) { return __uint_as_float(u << 16); }
__device__ __forceinline__ float bfhi(unsigned u) { return __uint_as_float(u & 0xffff0000u); }
__device__ __forceinline__ float bf1(bf16_t b) { return __uint_as_float(((unsigned)b) << 16); }
__device__ __forceinline__ f32x4 unpk4(u32x2 w) { return (f32x4){bflo(w.x), bfhi(w.x), bflo(w.y), bfhi(w.y)}; }
__device__ __forceinline__ u32x2 pack4(f32x4 v) { u32x2 w; w.x = pk2(v[0], v[1]); w.y = pk2(v[2], v[3]); return w; }
__device__ __forceinline__ float wave_sum(float v) {
#pragma unroll
    for (int o = 1; o < 64; o <<= 1) v += __shfl_xor(v, o);
    return v;
}
__device__ __forceinline__ float wave_max(float v) {
#pragma unroll
    for (int o = 1; o < 64; o <<= 1) v = fmaxf(v, __shfl_xor(v, o));
    return v;
}
__device__ __forceinline__ float ex2(float x) { return __builtin_amdgcn_exp2f(x); }
__device__ __forceinline__ float rcp(float x) { return __builtin_amdgcn_rcpf(x); }
__device__ __forceinline__ float sigm(float x) { return rcp(1.0f + ex2(-1.4426950408889634f * x)); }
__device__ __forceinline__ float silu(float x) { return x * sigm(x); }
__device__ __forceinline__ float gelu_t(float x) { const float u = x * (1.0f + 0.044715f * x * x); return x * rcp(1.0f + ex2(-2.3022081982f * u)); }
__device__ __forceinline__ float dot4(f32x4 a, f32x4 b) { return (a[0] * b[0] + a[1] * b[1]) + (a[2] * b[2] + a[3] * b[3]); }
__device__ __forceinline__ float hsum4(f32x4 a) { return (a[0] + a[1]) + (a[2] + a[3]); }
__device__ __forceinline__ float log2gamma(int h) { return log2f(1.0f - exp2f(-5.0f - (float)h)); }

__device__ __forceinline__ int launder(int v) { asm volatile("" : "+v"(v)); return v; }
__device__ __forceinline__ bf16x8 tr_frag(LAS const unsigned char* img, int pitch, int k0, int c0, int lane) {
    const int g = lane >> 4, q = (lane & 15) >> 2, p = lane & 3;
    LAS const unsigned char* a = img + (k0 + 8 * g + q) * pitch + (c0 + 4 * p) * 2;
    const s16x4 lo = __builtin_amdgcn_ds_read_tr16_b64_v4i16((LAS s16x4*)a);
    const s16x4 hi = __builtin_amdgcn_ds_read_tr16_b64_v4i16((LAS s16x4*)(a + 4 * pitch));
    return (bf16x8){lo[0], lo[1], lo[2], lo[3], hi[0], hi[1], hi[2], hi[3]};
}
__device__ __forceinline__ f32x4 mma(f32x4 acc, bf16x8 fcols, bf16x8 frows) { return __builtin_amdgcn_mfma_f32_16x16x32_bf16(fcols, frows, acc, 0, 0, 0); }

#define XB_TMO      128
#define XB_XCNT(j)  (256  + 64 * (j))
#define XB_XSUB(j)  (1280 + 64 * (j))
#define XB_XGEN(j)  (2304 + 64 * (j))
#define XB_TOP      3328
#define XB_TOPGEN   3392
#define XCD_BAR_WORDS 3456
#define XB_SPIN_CAP (1u << 22)
__device__ __forceinline__ unsigned xb_ld(unsigned* p)              { return __hip_atomic_load(p, __ATOMIC_RELAXED, __HIP_MEMORY_SCOPE_AGENT); }
__device__ __forceinline__ unsigned xb_add(unsigned* p, unsigned v) { return __hip_atomic_fetch_add(p, v, __ATOMIC_RELAXED, __HIP_MEMORY_SCOPE_AGENT); }
__device__ __forceinline__ unsigned xb_xcc_id() { return (unsigned)__builtin_amdgcn_s_getreg((3 << 11) | 20) & 0xFu; }
#define XB_SPIN(cond, bar) do { unsigned _sp = 0; while (cond) { __builtin_amdgcn_s_sleep(1); \
    if ((++_sp & 255u) == 0u) { if (xb_ld(&(bar)[XB_TMO])) break; if (_sp > XB_SPIN_CAP) { atomicAdd(&(bar)[XB_TMO], 1u); break; } } } } while (0)
struct XcdBarrier { unsigned* bar; unsigned x; volatile LAS unsigned* st; };
__device__ __forceinline__ XcdBarrier xcd_barrier_post(unsigned* bar, volatile LAS unsigned* st) {
    XcdBarrier b; b.bar = bar; b.x = xb_xcc_id(); b.st = st;
    if (threadIdx.x == 0) (void)xb_add(&bar[XB_XCNT(b.x)], 1u);
    return b;
}
__device__ __forceinline__ void xcd_barrier_complete(unsigned* bar, unsigned x, unsigned& nloc, unsigned& nx) {
    const unsigned G = gridDim.x * gridDim.y * gridDim.z;
    unsigned sum, cnt, mine, sp = 0u;
    for (;;) {
        sum = 0u; cnt = 0u; mine = 0u;
#pragma unroll
        for (unsigned j = 0; j < 16; ++j) { const unsigned c = xb_ld(&bar[XB_XCNT(j)]); sum += c; cnt += (c > 0u) ? 1u : 0u; mine = (j == x) ? c : mine; }
        if (sum == G) break;
        __builtin_amdgcn_s_sleep(1);
        if ((++sp & 255u) == 0u) { if (xb_ld(&bar[XB_TMO])) break; if (sp > XB_SPIN_CAP) { atomicAdd(&bar[XB_TMO], 1u); break; } }
    }
    nloc = mine > 0u ? mine : 1u; nx = cnt > 0u ? cnt : 1u;
}
__device__ __forceinline__ void xcd_barrier(const XcdBarrier& b) {
    asm volatile("s_waitcnt vmcnt(0)" ::: "memory");
    __syncthreads();
    if (threadIdx.x == 0) {
        unsigned* bar = b.bar;
        __builtin_amdgcn_s_waitcnt(0);
        unsigned nloc = b.st[0], nx = b.st[1];
        if (nloc == 0u) { xcd_barrier_complete(bar, b.x, nloc, nx); b.st[0] = nloc; b.st[1] = nx; }
        const unsigned old = xb_add(&bar[XB_XSUB(b.x)], 1u);
        const unsigned gen = old / nloc;
        if (old + 1u == (gen + 1u) * nloc) {
            __builtin_amdgcn_fence(__ATOMIC_RELEASE, "agent");
            asm volatile("s_waitcnt vmcnt(0)" ::: "memory");
            const unsigned og = xb_add(&bar[XB_TOP], 1u);
            const unsigned tg = og / nx;
            if (og + 1u == (tg + 1u) * nx) xb_add(&bar[XB_TOPGEN], 1u);
            else XB_SPIN(xb_ld(&bar[XB_TOPGEN]) == tg, bar);
            __builtin_amdgcn_fence(__ATOMIC_ACQUIRE, "agent");
            xb_add(&bar[XB_XGEN(b.x)], 1u);
            asm volatile("s_waitcnt vmcnt(0)" ::: "memory");
        } else {
            XB_SPIN(xb_ld(&bar[XB_XGEN(b.x)]) == gen, bar);
            __builtin_amdgcn_fence(__ATOMIC_ACQUIRE, "agent");
            asm volatile("s_waitcnt vmcnt(0)" ::: "memory");
        }
    }
    __syncthreads();
}

struct Frame {
    LAS unsigned char* lds;
    int tid, lane, wave, G, cu;
    const float *xp, *xs, *state, *cmk, *cmv, *memp, *g_pre, *w_in, *g_anorm, *w_s, *b_s, *g_ret, *g_mem, *w_mem, *w_oa, *w_ob, *w_oc, *w_out, *g_final;
    float* out; unsigned char* ws;
    bf16_t *WinT, *WmemT, *WoaT, *WobT, *WocT, *WoutT, *H, *MEMN, *Z, *MKV, *RS, *AACT, *BACT, *CACT, *MG;
    float *ropec, *ropes, *statv, *stato, *stats, *SH, *SW, *sA, *sB, *sC, *sM, *SWa, *SWb, *SWc, *SWo; unsigned* CMAX; unsigned char *H8, *W8, *A8, *B8, *C8, *M8, *W8a, *W8b, *W8c, *W8o;
};

template <bool I8> struct EpiZ {
    static constexpr bool PERM = true;
    bf16_t* Z; float* statv; const float* ropec; const float* ropes; const float* sh; const float* sw;
    template <int ACT> __device__ __forceinline__ void ew(const f32x4 (&acc)[2][2][4][2], int pn, int row0, int wc, int fq) const {
        bf16_t* zb = Z + (size_t)pn * 256 + wc * 32 + 8 * fq;
#pragma unroll
        for (int ai = 0; ai < 2; ++ai)
#pragma unroll
            for (int m = 0; m < 4; ++m) { const size_t row = (size_t)(row0 + ai * 128 + m * 16); float s = 0.f, q = 0.f;
#pragma unroll
                for (int bj = 0; bj < 2; ++bj) { f32x4 v0 = acc[ai][bj][m][0], v1 = acc[ai][bj][m][1];
#pragma unroll
                    for (int e = 0; e < 4; ++e) {
                        if (ACT == 1 || ACT == 2) { v0[e] = gelu_t(v0[e]); v1[e] = gelu_t(v1[e]); }
                        if (ACT == 3) { v0[e] = silu(v0[e]); v1[e] = silu(v1[e]); }
                        if (ACT == 4) { v0[e] = v0[e] * 0.0625f; v1[e] = v1[e] * 0.0625f; }
                        if (ACT == 5) { v0[e] = sigm(v0[e]); v1[e] = sigm(v1[e]); } }
                    if (ACT == 2) { s += hsum4(v0) + hsum4(v1); q += dot4(v0, v0) + dot4(v1, v1); }
                    u32x4 w; w.x = pk2(v0[0], v0[1]); w.y = pk2(v0[2], v0[3]); w.z = pk2(v1[0], v1[1]); w.w = pk2(v1[2], v1[3]);
                    *(u32x4*)(zb + row * LDZ + bj * 128) = w; }
                if (ACT == 2) { s += __shfl_xor(s, 16); s += __shfl_xor(s, 32); q += __shfl_xor(q, 16); q += __shfl_xor(q, 32);
                    if (fq == 0) *(f32x2*)(statv + (row * 32 + (pn - 8) * 4 + wc) * 2) = (f32x2){s, q}; } }
    }
    __device__ __forceinline__ void rot(const f32x4 (&acc)[2][2][4][2], int pn, int row0, int wc, int fq) const {
        const float sc = (pn >= 32) ? 0.0625f : 1.0f; bf16_t* zb = Z + (size_t)pn * 256 + wc * 32 + 8 * fq;
#pragma unroll
        for (int ai = 0; ai < 2; ++ai)
#pragma unroll
            for (int m = 0; m < 4; ++m) { const int row = row0 + ai * 128 + m * 16; const int p = row < MP ? (row & 2047) : 2048; const size_t ti = (size_t)p * 128 + wc * 32 + 8 * fq;
                const f32x4 c0 = *(const f32x4*)(ropec + ti) * sc, c1 = *(const f32x4*)(ropec + ti + 4) * sc, s0 = *(const f32x4*)(ropes + ti) * sc, s1 = *(const f32x4*)(ropes + ti + 4) * sc;
                const f32x4 a0 = acc[ai][0][m][0], a1 = acc[ai][0][m][1], b0 = acc[ai][1][m][0], b1 = acc[ai][1][m][1];
                const f32x4 x0 = a0 * c0 - b0 * s0, x1 = a1 * c1 - b1 * s1, y0 = a0 * s0 + b0 * c0, y1 = a1 * s1 + b1 * c1;
                u32x4 w; w.x = pk2(x0[0], x0[1]); w.y = pk2(x0[2], x0[3]); w.z = pk2(x1[0], x1[1]); w.w = pk2(x1[2], x1[3]);
                *(u32x4*)(zb + (size_t)row * LDZ) = w;
                w.x = pk2(y0[0], y0[1]); w.y = pk2(y0[2], y0[3]); w.z = pk2(y1[0], y1[1]); w.w = pk2(y1[2], y1[3]);
                *(u32x4*)(zb + (size_t)row * LDZ + 128) = w;
                asm volatile("" ::: "memory"); }
    }
    __device__ __forceinline__ void operator()(f32x4 (&acc)[2][2][4][2], const pg8::Unit& u, int wr, int wc, int fr, int fq) const {
        const int row0 = u.pm * 256 + wr * 64 + fr;
        const int pn = I8 ? (u.pn < 32 ? u.pn : u.pn + 16) : u.pn;
        if (I8) {
            if (u.pm == 32 && pn >= 8 && pn < 16) return;
            const int col0 = pn * 256 + wc * 32 + 8 * fq; f32x4 swv[2][2];
#pragma unroll
            for (int bj = 0; bj < 2; ++bj)
#pragma unroll
                for (int n = 0; n < 2; ++n) swv[bj][n] = *(const f32x4*)(sw + col0 + bj * 128 + 4 * n);
#pragma unroll
            for (int ai = 0; ai < 2; ++ai)
#pragma unroll
                for (int m = 0; m < 4; ++m) { const float hs = sh[row0 + ai * 128 + m * 16];
#pragma unroll
                    for (int bj = 0; bj < 2; ++bj)
#pragma unroll
                        for (int n = 0; n < 2; ++n) { const i32x4 q = __builtin_bit_cast(i32x4, acc[ai][bj][m][n]);
                            acc[ai][bj][m][n] = (f32x4){(float)q[0], (float)q[1], (float)q[2], (float)q[3]} * (swv[bj][n] * hs); } }
        }
        if (pn < 8) ew<1>(acc, pn, row0, wc, fq);
        else if (pn < 16) ew<2>(acc, pn, row0, wc, fq);
        else if (pn < 24 || (pn >= 48 && pn < 56) || (pn >= 60 && pn < 64)) ew<3>(acc, pn, row0, wc, fq);
        else if (pn < 40) rot(acc, pn, row0, wc, fq);
        else if (pn < 48) ew<0>(acc, pn, row0, wc, fq);
        else if (pn < 60) ew<4>(acc, pn, row0, wc, fq);
        else ew<5>(acc, pn, row0, wc, fq);
    }
};
struct EpiMem {
    static constexpr bool PERM = true;
    float* omk; float* omv; bf16_t* mkv;
    __device__ __forceinline__ void operator()(f32x4 (&acc)[2][2][4][2], const pg8::Unit& u, int wr, int wc, int fr, int fq) const {
        const int row0 = u.pm * 256 + wr * 64 + fr;
        const int colt = u.pn * 256 + wc * 32 + 8 * fq; float* ob = (u.pn < 4) ? omk : omv; const int cc = colt & 1023;
#pragma unroll
        for (int ai = 0; ai < 2; ++ai)
#pragma unroll
            for (int m = 0; m < 4; ++m) { const size_t row = (size_t)(row0 + ai * 128 + m * 16);
#pragma unroll
                for (int bj = 0; bj < 2; ++bj) { const f32x4 v0 = acc[ai][bj][m][0], v1 = acc[ai][bj][m][1];
                    *(f32x4*)(ob + row * 1024 + cc + bj * 128) = v0; *(f32x4*)(ob + row * 1024 + cc + bj * 128 + 4) = v1;
                    u32x4 w; w.x = pk2(v0[0], v0[1]); w.y = pk2(v0[2], v0[3]); w.z = pk2(v1[0], v1[1]); w.w = pk2(v1[2], v1[3]);
                    *(u32x4*)(mkv + row * 2048 + colt + bj * 128) = w; } }
    }
};
struct EpiMerge {
    static constexpr bool PERM = true;
    const bf16_t* Z; bf16_t* MG; int pass;
    __device__ __forceinline__ void operator()(f32x4 (&acc)[2][2][4][2], const pg8::Unit& u, int wr, int wc, int fr, int fq) const {
        const int row0 = u.pm * 256 + wr * 64 + fr, col0 = u.pn * 256 + wc * 32 + 8 * fq;
#pragma unroll
        for (int ai = 0; ai < 2; ++ai)
#pragma unroll
            for (int m = 0; m < 4; ++m) { const size_t row = (size_t)(row0 + ai * 128 + m * 16);
#pragma unroll
                for (int bj = 0; bj < 2; ++bj) { const int c = col0 + bj * 128;
                    const u32x4 g = *(const u32x4*)(Z + row * LDZ + ZC_GS + pass * D + c);
                    f32x4 v0 = acc[ai][bj][m][0] * (f32x4){bflo(g.x), bfhi(g.x), bflo(g.y), bfhi(g.y)}, v1 = acc[ai][bj][m][1] * (f32x4){bflo(g.z), bfhi(g.z), bflo(g.w), bfhi(g.w)};
                    if (pass) { const u32x4 p = *(const u32x4*)(MG + row * D + c); v0 += (f32x4){bflo(p.x), bfhi(p.x), bflo(p.y), bfhi(p.y)}; v1 += (f32x4){bflo(p.z), bfhi(p.z), bflo(p.w), bfhi(p.w)}; }
                    u32x4 w; w.x = pk2(v0[0], v0[1]); w.y = pk2(v0[2], v0[3]); w.z = pk2(v1[0], v1[1]); w.w = pk2(v1[2], v1[3]);
                    *(u32x4*)(MG + row * D + c) = w; } }
    }
};
struct EpiOut {
    static constexpr bool PERM = false;
    const float* X; float* Y; float* stato;
    __device__ __forceinline__ void operator()(f32x4 (&acc)[2][2][4][2], const pg8::Unit& u, int wr, int wc, int fr, int fq) const {
        const int row0 = u.pm * 256 + wr * 64 + fr, col0 = u.pn * 256 + wc * 32 + 4 * fq;
#pragma unroll
        for (int ai = 0; ai < 2; ++ai)
#pragma unroll
            for (int m = 0; m < 4; ++m) { const size_t row = (size_t)(row0 + ai * 128 + m * 16); float q = 0.f;
#pragma unroll
                for (int bj = 0; bj < 2; ++bj)
#pragma unroll
                    for (int n = 0; n < 2; ++n) { const size_t o = row * D + col0 + bj * 128 + n * 16; const f32x4 v = *(const f32x4*)(X + o) + acc[ai][bj][m][n]; *(f32x4*)(Y + o) = v; q += dot4(v, v); }
                q += __shfl_xor(q, 16); q += __shfl_xor(q, 32);
                if (fq == 0) stato[row * 64 + u.pn * 4 + wc] = q; }
    }
};

struct EpiMerge8 {
    static constexpr bool PERM = true;
    const bf16_t* Z; bf16_t* MG; const float* sx; const float* sw; int pass;
    __device__ __forceinline__ void operator()(f32x4 (&acc)[2][2][4][2], const pg8::Unit& u, int wr, int wc, int fr, int fq) const {
        const int row0 = u.pm * 256 + wr * 64 + fr, col0 = u.pn * 256 + wc * 32 + 8 * fq; f32x4 swv[2][2];
#pragma unroll
        for (int bj = 0; bj < 2; ++bj)
#pragma unroll
            for (int n = 0; n < 2; ++n) swv[bj][n] = *(const f32x4*)(sw + col0 + bj * 128 + 4 * n);
#pragma unroll
        for (int ai = 0; ai < 2; ++ai)
#pragma unroll
            for (int m = 0; m < 4; ++m) { const size_t row = (size_t)(row0 + ai * 128 + m * 16); const float hs = sx[row];
#pragma unroll
                for (int bj = 0; bj < 2; ++bj) { const int c = col0 + bj * 128;
                    const u32x4 g = *(const u32x4*)(Z + row * LDZ + ZC_GS + pass * D + c);
                    const i32x4 q0 = __builtin_bit_cast(i32x4, acc[ai][bj][m][0]), q1 = __builtin_bit_cast(i32x4, acc[ai][bj][m][1]);
                    f32x4 v0 = (f32x4){(float)q0[0], (float)q0[1], (float)q0[2], (float)q0[3]} * (swv[bj][0] * hs) * (f32x4){bflo(g.x), bfhi(g.x), bflo(g.y), bfhi(g.y)};
                    f32x4 v1 = (f32x4){(float)q1[0], (float)q1[1], (float)q1[2], (float)q1[3]} * (swv[bj][1] * hs) * (f32x4){bflo(g.z), bfhi(g.z), bflo(g.w), bfhi(g.w)};
                    if (pass) { const u32x4 p = *(const u32x4*)(MG + row * D + c); v0 += (f32x4){bflo(p.x), bfhi(p.x), bflo(p.y), bfhi(p.y)}; v1 += (f32x4){bflo(p.z), bfhi(p.z), bflo(p.w), bfhi(p.w)}; }
                    u32x4 w; w.x = pk2(v0[0], v0[1]); w.y = pk2(v0[2], v0[3]); w.z = pk2(v1[0], v1[1]); w.w = pk2(v1[2], v1[3]);
                    *(u32x4*)(MG + row * D + c) = w; } }
    }
};
struct EpiOut8 {
    static constexpr bool PERM = false;
    const float* X; float* Y; float* stato; const float* sx; const float* sw;
    __device__ __forceinline__ void operator()(f32x4 (&acc)[2][2][4][2], const pg8::Unit& u, int wr, int wc, int fr, int fq) const {
        const int row0 = u.pm * 256 + wr * 64 + fr, col0 = u.pn * 256 + wc * 32 + 4 * fq; f32x4 swv[2][2];
#pragma unroll
        for (int bj = 0; bj < 2; ++bj)
#pragma unroll
            for (int n = 0; n < 2; ++n) swv[bj][n] = *(const f32x4*)(sw + col0 + bj * 128 + n * 16);
#pragma unroll
        for (int ai = 0; ai < 2; ++ai)
#pragma unroll
            for (int m = 0; m < 4; ++m) { const size_t row = (size_t)(row0 + ai * 128 + m * 16); float q = 0.f; const float hs = sx[row];
#pragma unroll
                for (int bj = 0; bj < 2; ++bj)
#pragma unroll
                    for (int n = 0; n < 2; ++n) { const size_t o = row * D + col0 + bj * 128 + n * 16; const i32x4 qi = __builtin_bit_cast(i32x4, acc[ai][bj][m][n]);
                        const f32x4 v = *(const f32x4*)(X + o) + (f32x4){(float)qi[0], (float)qi[1], (float)qi[2], (float)qi[3]} * (swv[bj][n] * hs); *(f32x4*)(Y + o) = v; q += dot4(v, v); }
                q += __shfl_xor(q, 16); q += __shfl_xor(q, 32);
                if (fq == 0) stato[row * 64 + u.pn * 4 + wc] = q; }
    }
};

__device__ __forceinline__ void p0_load_tile(float (&v)[32], const float* W, int N, int k0, int n0, int lane) {
    const float* src = W + (size_t)(k0 + (lane >> 5)) * N + n0 + (lane & 31);
#pragma unroll
    for (int i = 0; i < 32; ++i) v[i] = __builtin_nontemporal_load(src + (size_t)(2 * i) * N);
}
template <int MODE> __device__ __forceinline__ void p0_transpose_tile(const float* W, int K, int N, int k0, int n0, bf16_t* WT, int nd0, LAS float* scr, int lane) {
    float v[32]; p0_load_tile(v, W, N, k0, n0, lane);
#pragma unroll
    for (int i = 0; i < 32; ++i) scr[(2 * i + (lane >> 5)) * 33 + (lane & 31)] = v[i];
    LDS_WAIT();
    const int c = lane & 7;
#pragma unroll
    for (int j = 0; j < 4; ++j) { const int n = (lane >> 3) + 8 * j; const LAS float* s = scr + (8 * c) * 33 + n;
        u32x4 o; o.x = pk2(s[0 * 33], s[1 * 33]); o.y = pk2(s[2 * 33], s[3 * 33]); o.z = pk2(s[4 * 33], s[5 * 33]); o.w = pk2(s[6 * 33], s[7 * 33]);
        if (MODE == 0) *(u32x4*)(WT + (size_t)(nd0 + n) * K + k0 + 8 * c) = o;
        else { const int nn = nd0 + n; *(u32x4*)((unsigned char*)WT + img_off(MODE == 2 ? perm_slot(nn) : nn, k0 + 8 * c, K)) = o; } }
    LDS_WAIT();
}
template <int MODE> __device__ __forceinline__ void p0_transpose_item(const float* W, int K, int N, bf16_t* WT, LAS float* scr, int item, int lane) {
    const int nblk = N / 32, kb = item / nblk, nb = item % nblk; p0_transpose_tile<MODE>(W, K, N, 64 * kb, 32 * nb, WT, 32 * nb, scr, lane);
}
__device__ __forceinline__ int i8_col0(int nb8) { return nb8 < 256 ? nb8 * 32 : nb8 * 32 + 4096; }
__device__ __forceinline__ void p0_absmax_item(const Frame& F, int item, int lane) {
    const int kb = item / 768, nb8 = item % 768, n0 = i8_col0(nb8);
    float v[32]; p0_load_tile(v, F.w_in, NIN, 64 * kb, n0, lane); float m = 0.f;
#pragma unroll
    for (int i = 0; i < 32; ++i) m = fmaxf(m, fabsf(v[i]));
    m = fmaxf(m, __shfl_xor(m, 32));
    if (lane < 32) atomicMax(F.CMAX + n0 + lane, __float_as_uint(m));
}
__device__ __forceinline__ void p0_quant_item(const Frame& F, LAS float* scr, int item, int lane) {
    const int kb = item / 768, nb8 = item % 768, n0 = i8_col0(nb8), k0 = 64 * kb;
    float v[32]; p0_load_tile(v, F.w_in, NIN, k0, n0, lane);
    const float amax = __uint_as_float(F.CMAX[n0 + (lane & 31)]); const float sc = amax > 0.f ? 127.0f / amax : 0.f;
    if (kb == 0 && lane < 32) F.SW[n0 + lane] = amax * (1.0f / 127.0f);
    LAS int* si = (LAS int*)scr;
#pragma unroll
    for (int i = 0; i < 32; ++i) si[(2 * i + (lane >> 5)) * 33 + (lane & 31)] = (int)__builtin_rintf(v[i] * sc);
    LDS_WAIT();
    const int c = lane & 7;
#pragma unroll
    for (int j = 0; j < 4; ++j) { const int n = (lane >> 3) + 8 * j; const LAS int* q = si + (8 * c) * 33 + n;
        u32x2 o; o.x = (unsigned)(q[0] & 0xff) | ((unsigned)(q[33] & 0xff) << 8) | ((unsigned)(q[66] & 0xff) << 16) | ((unsigned)(q[99] & 0xff) << 24);
        o.y = (unsigned)(q[132] & 0xff) | ((unsigned)(q[165] & 0xff) << 8) | ((unsigned)(q[198] & 0xff) << 16) | ((unsigned)(q[231] & 0xff) << 24);
        *(u32x2*)(F.W8 + img8_off(perm_slot(nb8 * 32 + n), k0 + 8 * c, D)) = o; }
    LDS_WAIT();
}
template <bool Q8> __device__ __forceinline__ void rms_row(const float* xrow, const float* g, bf16_t* obase, int m, int lane, unsigned char* o8, float* sh) {
    const f32x4* xr = (const f32x4*)xrow + lane; f32x4 v[16]; float s = 0.f;
#pragma unroll
    for (int j = 0; j < 16; ++j) { v[j] = xr[64 * j]; s += dot4(v[j], v[j]); }
    const float r = 1.0f / sqrtf(wave_sum(s) * (1.0f / 4096.0f) + EPS);
    const f32x4* gr = (const f32x4*)g + lane; float am = 0.f;
#pragma unroll
    for (int j = 0; j < 16; ++j) { v[j] = v[j] * r * gr[64 * j]; *(u32x2*)((unsigned char*)obase + img_off(m, 4 * lane + 256 * j, D)) = pack4(v[j]);
        if (Q8) am = fmaxf(am, fmaxf(fmaxf(fabsf(v[j][0]), fabsf(v[j][1])), fmaxf(fabsf(v[j][2]), fabsf(v[j][3])))); }
    if (Q8) { am = wave_max(am); const float sc = am > 0.f ? 127.0f / am : 0.f; if (lane == 0) sh[m] = am * (1.0f / 127.0f);
#pragma unroll
        for (int j = 0; j < 16; ++j) { const int q0 = (int)__builtin_rintf(v[j][0] * sc), q1 = (int)__builtin_rintf(v[j][1] * sc), q2 = (int)__builtin_rintf(v[j][2] * sc), q3 = (int)__builtin_rintf(v[j][3] * sc);
            *(unsigned*)(o8 + img8_off(m, 4 * lane + 256 * j, D)) = (unsigned)(q0 & 0xff) | ((unsigned)(q1 & 0xff) << 8) | ((unsigned)(q2 & 0xff) << 16) | ((unsigned)(q3 & 0xff) << 24); } }
}
template <int K> __device__ __forceinline__ void quant_row(const bf16_t* src, unsigned char* dst, int slot, float* sc, int lane) {
    constexpr int NCH = K / 512; u32x4 raw[NCH]; float am = 0.f;
#pragma unroll
    for (int i = 0; i < NCH; ++i) { raw[i] = *(const u32x4*)(src + 8 * (lane + 64 * i));
        const unsigned w[4] = {raw[i].x, raw[i].y, raw[i].z, raw[i].w};
#pragma unroll
        for (int e = 0; e < 4; ++e) am = fmaxf(am, fmaxf(fabsf(bflo(w[e])), fabsf(bfhi(w[e])))); }
    am = wave_max(am); const float s = am > 0.f ? 127.0f / am : 0.f; if (lane == 0) *sc = am * (1.0f / 127.0f);
#pragma unroll
    for (int i = 0; i < NCH; ++i) { const unsigned w[4] = {raw[i].x, raw[i].y, raw[i].z, raw[i].w}; unsigned o[2];
#pragma unroll
        for (int h = 0; h < 2; ++h) { const int q0 = (int)__builtin_rintf(bflo(w[2 * h]) * s), q1 = (int)__builtin_rintf(bfhi(w[2 * h]) * s), q2 = (int)__builtin_rintf(bflo(w[2 * h + 1]) * s), q3 = (int)__builtin_rintf(bfhi(w[2 * h + 1]) * s);
            o[h] = (unsigned)(q0 & 0xff) | ((unsigned)(q1 & 0xff) << 8) | ((unsigned)(q2 & 0xff) << 16) | ((unsigned)(q3 & 0xff) << 24); }
        *(u32x2*)(dst + img8_off(slot, 8 * (lane + 64 * i), K)) = (u32x2){o[0], o[1]}; }
}
__device__ __forceinline__ void p0a_prologue(const Frame& F) {
    LAS float* scr = (LAS float*)(F.lds + F.wave * 8448);
    const int gw = F.cu * 8 + F.wave, NGW = F.G * 8;
    constexpr int I_AMAX = 64 * 768, I_STR = 64 * 192, I_MEM = (D / 64) * (2048 / 32), I_OA = (AW / 64) * (D / 32), I_OB = (RW / 64) * (D / 32), I_OC = (MW / 64) * (D / 32), I_OUT = (D / 64) * (D / 32);
    constexpr int NITEMS = I_AMAX + I_STR + I_MEM + I_OA + I_OB + I_OC + I_OUT;
    for (int it = gw; it < NITEMS; it += NGW) {
        int r = it;
        if (r < I_AMAX) { p0_absmax_item(F, r, F.lane); continue; } r -= I_AMAX;
        if (r < I_STR) { const int kb = r / 192, nb = r % 192; const int n0 = nb < 64 ? 2048 + nb * 32 : 8192 + (nb - 64) * 32;
            p0_transpose_tile<2>(F.w_in, D, NIN, 64 * kb, n0, F.WinT, n0, scr, F.lane); continue; } r -= I_STR;
        if (r < I_MEM) { p0_transpose_item<2>(F.w_mem, D, 2048, F.WmemT, scr, r, F.lane); continue; } r -= I_MEM;
        if (r < I_OA) { p0_transpose_item<0>(F.w_oa, AW, D, F.WoaT, scr, r, F.lane); continue; } r -= I_OA;
        if (r < I_OB) { p0_transpose_item<0>(F.w_ob, RW, D, F.WobT, scr, r, F.lane); continue; } r -= I_OB;
        if (r < I_OC) { p0_transpose_item<0>(F.w_oc, MW, D, F.WocT, scr, r, F.lane); continue; } r -= I_OC;
        p0_transpose_item<0>(F.w_out, D, D, F.WoutT, scr, r, F.lane);
    }
    for (int m = gw; m < MPAD + 1024; m += NGW) {
        if (m < MP) rms_row<true>(F.xp + (size_t)m * D, F.g_pre, F.H, m, F.lane, F.H8, F.SH);
        else if (m < MREAL) rms_row<true>(F.xs + (size_t)(m - MP) * D, F.g_pre, F.H, m, F.lane, F.H8, F.SH);
        else if (m < MPAD) { u32x4* o = (u32x4*)((unsigned char*)F.H + (size_t)(MREAL >> 7) * 64 * 16384 + (size_t)(m - MREAL) * 8192) + F.lane;
#pragma unroll
            for (int j = 0; j < 8; ++j) o[64 * j] = (u32x4){0u, 0u, 0u, 0u};
            u32x4* o2 = (u32x4*)(F.H8 + (size_t)(MREAL >> 7) * 32 * 16384 + (size_t)(m - MREAL) * 4096) + F.lane;
#pragma unroll
            for (int j = 0; j < 4; ++j) o2[64 * j] = (u32x4){0u, 0u, 0u, 0u};
            if (F.lane == 0) F.SH[m] = 0.f; }
        else rms_row<false>(F.memp + (size_t)(m - MPAD) * D, F.g_mem, F.MEMN, m - MPAD, F.lane, nullptr, nullptr);
    }
    for (int idx = F.cu * 512 + F.tid; idx < 2049 * 128; idx += F.G * 512) {
        const int p = idx >> 7, j = idx & 127; const int pos = p < 2048 ? p : 16384;
        double iv = 1.0, bs = 0.9305720409296989; for (int e = j; e > 0; e >>= 1) { if (e & 1) iv *= bs; bs *= bs; }
        const float inv = (float)iv; const float ang = (float)pos * inv;
        const double x = (double)ang; const double n = __builtin_rint(x * 0.15915494309189535);
        const double r = __builtin_fma(-n, 2.4492935982947064e-16, __builtin_fma(-n, 6.283185307179586, x)); const double r2 = r * r;
        double sn = r, tm = r, cs = 1.0, tc = 1.0;
#pragma unroll
        for (int k = 1; k <= 13; ++k) { tm *= -r2 * (1.0 / (double)((2 * k) * (2 * k + 1))); sn += tm; tc *= -r2 * (1.0 / (double)((2 * k - 1) * (2 * k))); cs += tc; }
        F.ropec[idx] = (float)cs; F.ropes[idx] = (float)sn;
    }
}

template <int NROWS>
__device__ __forceinline__ void stage_tile256(LAS unsigned char* img, const bf16_t* src, size_t ld, int tid) {
    constexpr int PER = NROWS * 32 / 512;
#pragma unroll
    for (int b0 = 0; b0 < PER; b0 += 8) {
        u32x4 v[8];
#pragma unroll
        for (int i = 0; i < 8; ++i) { const int ch = tid + 512 * (b0 + i), row = ch >> 5, cc = ch & 31; v[i] = *(const u32x4*)(src + (size_t)row * ld + cc * 8); }
#pragma unroll
        for (int i = 0; i < 8; ++i) { const int ch = tid + 512 * (b0 + i), row = ch >> 5, cc = ch & 31; *(LAS u32x4*)(img + row * IMG_PITCH + cc * 16) = v[i]; }
    }
}

__device__ __forceinline__ void scan_unit(const Frame& F, int b, int h, int sl) {
    LAS unsigned char* imgK = F.lds; LAS unsigned char* imgV = F.lds + 67584;
    const int w = F.wave, tid = launder(F.tid), lane = tid & 63, fr = lane & 15, fq = lane >> 4;
    const float l2g = log2gamma(h); const float dblk = ex2(128.0f * l2g);
    f32x4 acc[2][2];
#pragma unroll
    for (int a = 0; a < 2; ++a)
#pragma unroll
        for (int k = 0; k < 2; ++k) acc[a][k] = (f32x4){0.f, 0.f, 0.f, 0.f};
    u32x4 kv[2][8], vraw[2]; const int vj = tid >> 2, vcc = tid & 3;
    const bf16_t* kbase = F.Z + ((size_t)b * 2048) * LDZ + ZC_K + h * 256; const bf16_t* vbase = F.Z + ((size_t)b * 2048 + vj) * LDZ + ZC_RV + h * 256 + sl * 32 + vcc * 8;
#define SCAN_LOAD(set, c_) do { const bf16_t* kb_ = kbase + (size_t)(c_) * 128 * LDZ; _Pragma("unroll") for (int i = 0; i < 8; ++i) { const int ch = tid + 512 * i; kv[set][i] = *(const u32x4*)(kb_ + (size_t)(ch >> 5) * LDZ + (ch & 31) * 8); } \
        vraw[set] = *(const u32x4*)(vbase + (size_t)(c_) * 128 * LDZ); } while (0)
    SCAN_LOAD(0, 0); SCAN_LOAD(1, 1);
    const float vsc = ex2((float)(127 - vj) * l2g);
    for (int c2 = 0; c2 < 16; c2 += 2) {
#pragma unroll
        for (int set = 0; set < 2; ++set) { const int c = c2 + set;
            __syncthreads();
#pragma unroll
            for (int i = 0; i < 8; ++i) { const int ch = tid + 512 * i; *(LAS u32x4*)(imgK + (ch >> 5) * IMG_PITCH + (ch & 31) * 16) = kv[set][i]; }
            { const u32x4 r = vraw[set]; u32x4 o; o.x = pk2(bflo(r.x) * vsc, bfhi(r.x) * vsc); o.y = pk2(bflo(r.y) * vsc, bfhi(r.y) * vsc); o.z = pk2(bflo(r.z) * vsc, bfhi(r.z) * vsc); o.w = pk2(bflo(r.w) * vsc, bfhi(r.w) * vsc);
              *(LAS u32x4*)(imgV + vj * 80 + vcc * 16) = o; }
            __syncthreads();
            if (c + 2 < 16) SCAN_LOAD(set, c + 2);
#pragma unroll
            for (int a = 0; a < 2; ++a)
#pragma unroll
                for (int k = 0; k < 2; ++k) acc[a][k] = acc[a][k] * dblk;
#pragma unroll
            for (int s = 0; s < 4; ++s) {
                bf16x8 fv[2], fk[2];
#pragma unroll
                for (int a = 0; a < 2; ++a) { fv[a] = tr_frag(imgV, 80, 32 * s, 16 * a, lane); fk[a] = tr_frag(imgK, IMG_PITCH, 32 * s, 32 * w + 16 * a, lane); }
#pragma unroll
                for (int a = 0; a < 2; ++a)
#pragma unroll
                    for (int k = 0; k < 2; ++k) acc[a][k] = mma(acc[a][k], fk[k], fv[a]);
            }
            if (c < 15) {
                bf16_t* rs = F.RS + ((size_t)(b * 8 + h) * 15 + c) * 65536;
#pragma unroll
                for (int a = 0; a < 2; ++a)
#pragma unroll
                    for (int k = 0; k < 2; ++k) *(u32x2*)(rs + (size_t)(sl * 32 + 16 * a + fr) * 256 + 32 * w + 16 * k + 4 * fq) = pack4(acc[a][k]);
            }
        }
    }
#undef SCAN_LOAD
    float* rp = F.out + O_RP + (size_t)(b * 8 + h) * 65536;
#pragma unroll
    for (int a = 0; a < 2; ++a)
#pragma unroll
        for (int k = 0; k < 2; ++k)
#pragma unroll
            for (int e = 0; e < 4; ++e) rp[(size_t)(32 * w + 16 * k + 4 * fq + e) * 256 + sl * 32 + 16 * a + fr] = acc[a][k][e];
}

__device__ __forceinline__ void spatial_unit(const Frame& F, int b, int c, int g, int hf) {
    LAS unsigned char* img = F.lds; LAS float* st = (LAS float*)(F.lds + SMALL_OFF);
    const int w = F.wave, tid = launder(F.tid), lane = tid & 63, fr = lane & 15, fq = lane >> 4;
    const size_t r0 = (size_t)b * 2048 + c * 128; const int ch0 = g * 512 + hf * 256;
    __syncthreads();
    if (tid < 128) { const f32x4* p = (const f32x4*)(F.statv + (r0 + tid) * 64); float s = 0.f, q = 0.f;
#pragma unroll
        for (int k = 0; k < 16; ++k) { const f32x4 t = p[k]; s += t[0] + t[2]; q += t[1] + t[3]; }
        const float mu = s * (1.0f / 2048.0f); const float var = fmaxf(q * (1.0f / 2048.0f) - mu * mu, 0.f);
        st[2 * tid] = mu; st[2 * tid + 1] = 1.0f / sqrtf(var + EPS); }
    __syncthreads();
#pragma unroll
    for (int i = 0; i < 8; ++i) { const int chk = tid + 512 * i, row = chk >> 5, cc = chk & 31;
        const u32x4 raw = *(const u32x4*)(F.Z + (r0 + row) * LDZ + ZC_V + ch0 + cc * 8);
        const f32x4 ga = *(const f32x4*)(F.g_anorm + ch0 + cc * 8), gb = *(const f32x4*)(F.g_anorm + ch0 + cc * 8 + 4);
        const float mu = st[2 * row], rs = st[2 * row + 1];
        u32x4 o; o.x = pk2((bflo(raw.x) - mu) * rs * ga[0], (bfhi(raw.x) - mu) * rs * ga[1]); o.y = pk2((bflo(raw.y) - mu) * rs * ga[2], (bfhi(raw.y) - mu) * rs * ga[3]);
        o.z = pk2((bflo(raw.z) - mu) * rs * gb[0], (bfhi(raw.z) - mu) * rs * gb[1]); o.w = pk2((bflo(raw.w) - mu) * rs * gb[2], (bfhi(raw.w) - mu) * rs * gb[3]);
        *(LAS u32x4*)(img + row * IMG_PITCH + cc * 16) = o; }
    __syncthreads();
    const int i = 16 * w + fr;
    bf16x8 fw[4];
#pragma unroll
    for (int s = 0; s < 4; ++s) { const int j0 = 32 * s + 8 * fq; const float* wp = F.w_s + (size_t)g * 16384 + i * 128 + j0; const f32x4 a = *(const f32x4*)wp, bq = *(const f32x4*)(wp + 4);
        float t[8] = {a[0], a[1], a[2], a[3], bq[0], bq[1], bq[2], bq[3]};
#pragma unroll
        for (int e = 0; e < 8; ++e) t[e] = (j0 + e <= i) ? t[e] : 0.f;
        const unsigned p0 = pk2(t[0], t[1]), p1 = pk2(t[2], t[3]), p2 = pk2(t[4], t[5]), p3 = pk2(t[6], t[7]);
        const u32x4 pw = (u32x4){p0, p1, p2, p3}; fw[s] = __builtin_bit_cast(bf16x8, pw); }
    f32x4 acc[16];
#pragma unroll
    for (int n = 0; n < 16; ++n) acc[n] = (f32x4){0.f, 0.f, 0.f, 0.f};
    const int smax = w >> 1;
#pragma unroll
    for (int s = 0; s < 4; ++s) if (s <= smax) {
#pragma unroll
        for (int n = 0; n < 16; ++n) { acc[n] = mma(acc[n], tr_frag(img, IMG_PITCH, 32 * s, 16 * n, lane), fw[s]); if ((n & 3) == 3) __builtin_amdgcn_sched_barrier(0); }
    }
    const float bsv = F.b_s[g * 128 + i]; const bf16_t* zr = F.Z + (r0 + i) * LDZ; bf16_t* ar = F.AACT + (r0 + i) * AW;
#pragma unroll
    for (int n = 0; n < 16; ++n) { const int ch = ch0 + 16 * n + 4 * fq;
        const f32x4 uu = unpk4(*(const u32x2*)(zr + ZC_U + ch)), ag = unpk4(*(const u32x2*)(zr + ZC_G + ch));
        *(u32x2*)(ar + ch) = pack4(uu * (acc[n] + bsv) * ag); }
}
__device__ __forceinline__ void spatial_sample_row(const Frame& F, int s) {
    const int lane = launder(F.lane); const size_t row = (size_t)MP + s;
    float sm = 0.f, sq = 0.f; if (lane < 32) { const f32x2 t = *(const f32x2*)(F.statv + (row * 32 + lane) * 2); sm = t[0]; sq = t[1]; }
    sm = wave_sum(sm); sq = wave_sum(sq);
    const float mu = sm * (1.0f / 2048.0f); const float rs = 1.0f / sqrtf(fmaxf(sq * (1.0f / 2048.0f) - mu * mu, 0.f) + EPS);
    const bf16_t* zr = F.Z + row * LDZ;
#pragma unroll
    for (int g = 0; g < 4; ++g) { const int ch = g * 512 + lane * 8;
        const u32x4 rv = *(const u32x4*)(zr + ZC_V + ch), ru = *(const u32x4*)(zr + ZC_U + ch), rg = *(const u32x4*)(zr + ZC_G + ch);
        const f32x4 ga = *(const f32x4*)(F.g_anorm + ch), gb = *(const f32x4*)(F.g_anorm + ch + 4);
        const f32x4 v0 = ((f32x4){bflo(rv.x), bfhi(rv.x), bflo(rv.y), bfhi(rv.y)} - mu) * rs * ga, v1 = ((f32x4){bflo(rv.z), bfhi(rv.z), bflo(rv.w), bfhi(rv.w)} - mu) * rs * gb;
        *(f32x4*)(F.out + O_GV + (size_t)s * AW + ch) = v0; *(f32x4*)(F.out + O_GV + (size_t)s * AW + ch + 4) = v1;
        const float w00 = F.w_s[g * 16384], b0 = F.b_s[g * 128];
        const f32x4 a0 = (f32x4){bflo(ru.x), bfhi(ru.x), bflo(ru.y), bfhi(ru.y)} * (v0 * w00 + b0) * (f32x4){bflo(rg.x), bfhi(rg.x), bflo(rg.y), bfhi(rg.y)};
        const f32x4 a1 = (f32x4){bflo(ru.z), bfhi(ru.z), bflo(ru.w), bfhi(ru.w)} * (v1 * w00 + b0) * (f32x4){bflo(rg.z), bfhi(rg.z), bflo(rg.w), bfhi(rg.w)};
        u32x4 o; o.x = pk2(a0[0], a0[1]); o.y = pk2(a0[2], a0[3]); o.z = pk2(a1[0], a1[1]); o.w = pk2(a1[2], a1[3]);
        *(u32x4*)(F.AACT + row * AW + ch) = o; }
}
__device__ __forceinline__ void ret_sample_item(const Frame& F, int req, int h) {
    LAS float* qs = (LAS float*)F.lds; LAS float* ks = qs + 256; LAS float* red = qs + 512;
    const int w = F.wave, tid = launder(F.tid), lane = tid & 63; const size_t row = (size_t)MP + req; const bf16_t* zr = F.Z + row * LDZ;
    __syncthreads();
    if (tid < 256) { qs[tid] = bf1(zr[ZC_Q + h * 256 + tid]); ks[tid] = bf1(zr[ZC_K + h * 256 + tid]); }
    const f32x4 vv = unpk4(*(const u32x2*)(zr + ZC_RV + h * 256 + lane * 4));
    __syncthreads();
    const float gam = 1.0f - ex2(-5.0f - (float)h);
    const size_t base = ((size_t)(req * 8 + h) * 256) * 256 + lane * 4; const float* sp = F.state + base; float* op = F.out + O_RS + base;
    f32x4 o = (f32x4){0.f, 0.f, 0.f, 0.f};
#pragma unroll
    for (int i0 = 0; i0 < 2; ++i0) { f32x4 R[16];
#pragma unroll
        for (int j = 0; j < 16; ++j) { const int d = w + 8 * (i0 * 16 + j); R[j] = __builtin_nontemporal_load((const f32x4*)(sp + (size_t)d * 256)); }
#pragma unroll
        for (int j = 0; j < 16; ++j) { const int d = w + 8 * (i0 * 16 + j); const f32x4 rn = R[j] * gam + vv * ks[d]; __builtin_nontemporal_store(rn, (f32x4*)(op + (size_t)d * 256)); o += rn * qs[d]; } }
    *(LAS f32x4*)(red + w * 256 + lane * 4) = o;
    __syncthreads();
    if (w == 0) { f32x4 t = *(LAS f32x4*)(red + lane * 4);
#pragma unroll
        for (int k = 1; k < 8; ++k) t += *(LAS f32x4*)(red + k * 256 + lane * 4);
        const float mean = wave_sum(hsum4(t)) * (1.0f / 256.0f); const f32x4 d = t - mean; const float var = wave_sum(dot4(d, d)) * (1.0f / 256.0f); const float rs = 1.0f / sqrtf(var + EPS);
        const f32x4 gr = *(const f32x4*)(F.g_ret + h * 256 + lane * 4), rg = unpk4(*(const u32x2*)(zr + ZC_RG + h * 256 + lane * 4));
        *(u32x2*)(F.BACT + row * RW + h * 256 + lane * 4) = pack4(d * rs * gr * rg); }
}
__device__ __forceinline__ void xattn_sample_item(const Frame& F, int req, int mh) {
    LAS float* cq = (LAS float*)F.lds; LAS float* sc = cq + 256; LAS float* red = cq + 512; LAS float* misc = cq + 512 + 2048;
    const int w = F.wave, tid = launder(F.tid), lane = tid & 63; const size_t row = (size_t)MP + req; const bf16_t* zr = F.Z + row * LDZ;
    __syncthreads();
    if (tid < 256) cq[tid] = bf1(zr[ZC_CQ + mh * 256 + tid]);
    __syncthreads();
    { const int sub = lane >> 4, li = lane & 15; f32x4 cqr[4];
#pragma unroll
      for (int c = 0; c < 4; ++c) cqr[c] = *(LAS f32x4*)(cq + 4 * (li + 16 * c));
#pragma unroll
      for (int g0 = 0; g0 < 8; g0 += 4) { f32x4 kk[4][4];
#pragma unroll
          for (int g = 0; g < 4; ++g) { const int m = 32 * w + 4 * (g0 + g) + sub; const float* kp = F.cmk + (((size_t)req * 256 + m) * 4 + mh) * 256;
#pragma unroll
              for (int c = 0; c < 4; ++c) kk[g][c] = __builtin_nontemporal_load((const f32x4*)(kp + 4 * (li + 16 * c))); }
#pragma unroll
          for (int g = 0; g < 4; ++g) { float dsum = (dot4(kk[g][0], cqr[0]) + dot4(kk[g][1], cqr[1])) + (dot4(kk[g][2], cqr[2]) + dot4(kk[g][3], cqr[3]));
              dsum += __shfl_xor(dsum, 1); dsum += __shfl_xor(dsum, 2); dsum += __shfl_xor(dsum, 4); dsum += __shfl_xor(dsum, 8);
              if (li == 0) sc[32 * w + 4 * (g0 + g) + sub] = dsum; } } }
    __syncthreads();
    if (w == 0) { f32x4 s4 = *(LAS f32x4*)(sc + 4 * lane); const float mx = wave_max(fmaxf(fmaxf(s4[0], s4[1]), fmaxf(s4[2], s4[3])));
#pragma unroll
        for (int e = 0; e < 4; ++e) s4[e] = ex2((s4[e] - mx) * 1.4426950408889634f);
        const float sum = wave_sum(hsum4(s4)); *(LAS f32x4*)(sc + 4 * lane) = s4; if (lane == 0) misc[0] = 1.0f / sum; }
    __syncthreads();
    f32x4 o = (f32x4){0.f, 0.f, 0.f, 0.f};
#pragma unroll
    for (int i0 = 0; i0 < 2; ++i0) { f32x4 V[16];
#pragma unroll
        for (int j = 0; j < 16; ++j) { const int m = w + 8 * (i0 * 16 + j); V[j] = __builtin_nontemporal_load((const f32x4*)(F.cmv + (((size_t)req * 256 + m) * 4 + mh) * 256 + lane * 4)); }
#pragma unroll
        for (int j = 0; j < 16; ++j) { const int m = w + 8 * (i0 * 16 + j); o += V[j] * sc[m]; } }
    *(LAS f32x4*)(red + w * 256 + lane * 4) = o;
    __syncthreads();
    if (w == 0) { f32x4 t = *(LAS f32x4*)(red + lane * 4);
#pragma unroll
        for (int k = 1; k < 8; ++k) t += *(LAS f32x4*)(red + k * 256 + lane * 4);
        const f32x4 cg = unpk4(*(const u32x2*)(zr + ZC_CG + mh * 256 + lane * 4));
        *(u32x2*)(F.CACT + row * MW + mh * 256 + lane * 4) = pack4(t * misc[0] * cg); }
}

__device__ __forceinline__ void ret_out_unit(const Frame& F, int b, int h, int c) {
    LAS unsigned char* img = F.lds; const int w = F.wave, tid = launder(F.tid), lane = tid & 63, fr = lane & 15, fq = lane >> 4;
    LAS unsigned char* Pw = F.lds + 67584 + w * 4352;
    const size_t r0 = (size_t)b * 2048 + c * 128; const int i = 16 * w + fr; const float l2g = log2gamma(h);
    bf16x8 qf[8];
#pragma unroll
    for (int s = 0; s < 8; ++s) qf[s] = *(const bf16x8*)(F.Z + (r0 + i) * LDZ + ZC_Q + h * 256 + 32 * s + 8 * fq);
    f32x4 acc[16];
#pragma unroll
    for (int n = 0; n < 16; ++n) acc[n] = (f32x4){0.f, 0.f, 0.f, 0.f};
    __syncthreads();
    if (c > 0) {
        stage_tile256<256>(img, F.RS + ((size_t)(b * 8 + h) * 15 + (c - 1)) * 65536, 256, tid);
        __syncthreads();
#pragma unroll
        for (int n = 0; n < 16; ++n) {
#pragma unroll
            for (int s = 0; s < 8; ++s) acc[n] = mma(acc[n], *(const LAS bf16x8*)(img + (16 * n + fr) * IMG_PITCH + (32 * s + 8 * fq) * 2), qf[s]);
            __builtin_amdgcn_sched_barrier(0); }
        const float dq = ex2((float)(i + 1) * l2g);
#pragma unroll
        for (int n = 0; n < 16; ++n) acc[n] = acc[n] * dq;
        __syncthreads();
    }
    stage_tile256<128>(img, F.Z + r0 * LDZ + ZC_K + h * 256, LDZ, tid);
    __syncthreads();
#pragma unroll
    for (int n = 0; n < 8; ++n) {
        f32x4 sa = (f32x4){0.f, 0.f, 0.f, 0.f};
        if (n <= w) {
#pragma unroll
            for (int s = 0; s < 8; ++s) sa = mma(sa, *(const LAS bf16x8*)(img + (16 * n + fr) * IMG_PITCH + (32 * s + 8 * fq) * 2), qf[s]);
#pragma unroll
            for (int e = 0; e < 4; ++e) { const int dij = i - (16 * n + 4 * fq + e); sa[e] = dij >= 0 ? sa[e] * ex2((float)dij * l2g) : 0.f; }
        }
        *(LAS u32x2*)(Pw + fr * 272 + (16 * n + 4 * fq) * 2) = pack4(sa); __builtin_amdgcn_sched_barrier(0);
    }
    __syncthreads();
    stage_tile256<128>(img, F.Z + r0 * LDZ + ZC_RV + h * 256, LDZ, tid);
    __syncthreads();
    const int smax = w >> 1;
#pragma unroll
    for (int s = 0; s < 4; ++s) if (s <= smax) {
        const bf16x8 pf = *(const LAS bf16x8*)(Pw + fr * 272 + (32 * s + 8 * fq) * 2);
#pragma unroll
        for (int n = 0; n < 16; ++n) { acc[n] = mma(acc[n], tr_frag(img, IMG_PITCH, 32 * s, 16 * n, lane), pf); if ((n & 3) == 3) __builtin_amdgcn_sched_barrier(0); }
    }
    float sm = 0.f;
#pragma unroll
    for (int n = 0; n < 16; ++n) sm += hsum4(acc[n]);
    sm += __shfl_xor(sm, 16); sm += __shfl_xor(sm, 32); const float mean = sm * (1.0f / 256.0f);
    float sq = 0.f;
#pragma unroll
    for (int n = 0; n < 16; ++n) { acc[n] = acc[n] - mean; sq += dot4(acc[n], acc[n]); }
    sq += __shfl_xor(sq, 16); sq += __shfl_xor(sq, 32); const float rs = 1.0f / sqrtf(sq * (1.0f / 256.0f) + EPS);
    const bf16_t* zr = F.Z + (r0 + i) * LDZ + ZC_RG + h * 256; bf16_t* br = F.BACT + (r0 + i) * RW + h * 256;
#pragma unroll
    for (int n = 0; n < 16; ++n) { const int dv = 16 * n + 4 * fq; const f32x4 gr = *(const f32x4*)(F.g_ret + h * 256 + dv), rg = unpk4(*(const u32x2*)(zr + dv));
        *(u32x2*)(br + dv) = pack4(acc[n] * rs * gr * rg); }
}
__device__ __forceinline__ void xattn_unit(const Frame& F, int b, int mh, int qb) {
    LAS unsigned char* img = F.lds; const int w = F.wave, tid = launder(F.tid), lane = tid & 63, fr = lane & 15, fq = lane >> 4;
    LAS unsigned char* Pw = F.lds + w * 8448; LAS unsigned char* imgV = F.lds + 67584;
    const size_t r0 = (size_t)b * 2048 + qb * 128; const int i = 16 * w + fr;
    bf16x8 qf[8];
#pragma unroll
    for (int s = 0; s < 8; ++s) qf[s] = *(const bf16x8*)(F.Z + (r0 + i) * LDZ + ZC_CQ + mh * 256 + 32 * s + 8 * fq);
    __syncthreads();
    stage_tile256<256>(img, F.MKV + (size_t)(b * 256) * 2048 + mh * 256, 2048, tid);
    __syncthreads();
    f32x4 acc[16];
#pragma unroll
    for (int n = 0; n < 16; ++n) { acc[n] = (f32x4){0.f, 0.f, 0.f, 0.f};
#pragma unroll
        for (int s = 0; s < 8; ++s) acc[n] = mma(acc[n], *(const LAS bf16x8*)(img + (16 * n + fr) * IMG_PITCH + (32 * s + 8 * fq) * 2), qf[s]); __builtin_amdgcn_sched_barrier(0); }
    float mx = -3.0e38f;
#pragma unroll
    for (int n = 0; n < 16; ++n) mx = fmaxf(mx, fmaxf(fmaxf(acc[n][0], acc[n][1]), fmaxf(acc[n][2], acc[n][3])));
    mx = fmaxf(mx, __shfl_xor(mx, 16)); mx = fmaxf(mx, __shfl_xor(mx, 32));
    float sm = 0.f;
#pragma unroll
    for (int n = 0; n < 16; ++n) {
#pragma unroll
        for (int e = 0; e < 4; ++e) acc[n][e] = ex2((acc[n][e] - mx) * 1.4426950408889634f);
        sm += hsum4(acc[n]); }
    sm += __shfl_xor(sm, 16); sm += __shfl_xor(sm, 32); const float inv = 1.0f / sm;
    __syncthreads();
#pragma unroll
    for (int n = 0; n < 16; ++n) { *(LAS u32x2*)(Pw + fr * IMG_PITCH + (16 * n + 4 * fq) * 2) = pack4(acc[n]); acc[n] = (f32x4){0.f, 0.f, 0.f, 0.f}; }
#pragma unroll
    for (int hf = 0; hf < 2; ++hf) {
        stage_tile256<128>(imgV, F.MKV + (size_t)(b * 256 + hf * 128) * 2048 + 1024 + mh * 256, 2048, tid);
        __syncthreads();
#pragma unroll
        for (int s = 0; s < 4; ++s) { const bf16x8 pf = *(const LAS bf16x8*)(Pw + fr * IMG_PITCH + (hf * 128 + 32 * s + 8 * fq) * 2);
#pragma unroll
            for (int n = 0; n < 16; ++n) { acc[n] = mma(acc[n], tr_frag(imgV, IMG_PITCH, 32 * s, 16 * n, lane), pf); if ((n & 3) == 3) __builtin_amdgcn_sched_barrier(0); } }
        __syncthreads();
    }
    const bf16_t* zr = F.Z + (r0 + i) * LDZ + ZC_CG + mh * 256; bf16_t* cr = F.CACT + (r0 + i) * MW + mh * 256;
#pragma unroll
    for (int n = 0; n < 16; ++n) { const int dv = 16 * n + 4 * fq; *(u32x2*)(cr + dv) = pack4(acc[n] * inv * unpk4(*(const u32x2*)(zr + dv))); }
}

template <int K>
__device__ __forceinline__ f32x4 skinny_dot(const bf16_t* arow, const bf16_t* brow) {
    f32x4 a0 = (f32x4){0.f, 0.f, 0.f, 0.f}, a1 = a0, a2 = a0, a3 = a0;
#pragma unroll 2
    for (int s = 0; s < K / 32; s += 8) {
        bf16x8 fa[8], fb[8];
#pragma unroll
        for (int j = 0; j < 8; ++j) { fa[j] = *(const bf16x8*)(arow + 32 * (s + j)); fb[j] = *(const bf16x8*)(brow + 32 * (s + j)); }
        a0 = mma(a0, fb[0], fa[0]); a1 = mma(a1, fb[1], fa[1]); a2 = mma(a2, fb[2], fa[2]); a3 = mma(a3, fb[3], fa[3]);
        a0 = mma(a0, fb[4], fa[4]); a1 = mma(a1, fb[5], fa[5]); a2 = mma(a2, fb[6], fa[6]); a3 = mma(a3, fb[7], fa[7]);
    }
    return (a0 + a1) + (a2 + a3);
}

struct Args { const float* in[19]; float* out; unsigned char* ws; int ph_lo, ph_hi; };
__global__ void __launch_bounds__(512, 2) mega_fwd(Args args) {
    extern __shared__ __attribute__((aligned(16))) unsigned char lds[];
    Frame F;
    F.lds = (LAS unsigned char*)lds;
    volatile LAS unsigned* MISC = (volatile LAS unsigned*)(F.lds + MISC_OFF);
    F.tid = threadIdx.x; F.lane = F.tid & 63; F.wave = __builtin_amdgcn_readfirstlane(F.tid >> 6); F.G = gridDim.x; F.cu = blockIdx.x;
    F.xp = args.in[0]; F.xs = args.in[1]; F.state = args.in[2]; F.cmk = args.in[3]; F.cmv = args.in[4]; F.memp = args.in[5]; F.g_pre = args.in[6]; F.w_in = args.in[7]; F.g_anorm = args.in[8];
    F.w_s = args.in[9]; F.b_s = args.in[10]; F.g_ret = args.in[11]; F.g_mem = args.in[12]; F.w_mem = args.in[13]; F.w_oa = args.in[14]; F.w_ob = args.in[15]; F.w_oc = args.in[16]; F.w_out = args.in[17]; F.g_final = args.in[18];
    F.out = args.out; F.ws = args.ws; unsigned char* ws = args.ws;
    F.WinT = (bf16_t*)(ws + WS_WIN); F.WmemT = (bf16_t*)(ws + WS_WMEM); F.WoaT = (bf16_t*)(ws + WS_WOA); F.WobT = (bf16_t*)(ws + WS_WOB); F.WocT = (bf16_t*)(ws + WS_WOC); F.WoutT = (bf16_t*)(ws + WS_WOUT);
    F.H = (bf16_t*)(ws + WS_H); F.MEMN = (bf16_t*)(ws + WS_MEMN); F.Z = (bf16_t*)(ws + WS_Z); F.MKV = (bf16_t*)(ws + WS_MKV); F.RS = (bf16_t*)(ws + WS_RS);
    F.AACT = (bf16_t*)(ws + WS_AACT); F.BACT = (bf16_t*)(ws + WS_BACT); F.CACT = (bf16_t*)(ws + WS_CACT); F.MG = (bf16_t*)(ws + WS_MG);
    F.ropec = (float*)(ws + WS_ROPE); F.ropes = F.ropec + 2049 * 128; F.statv = (float*)(ws + WS_STATV); F.stato = (float*)(ws + WS_STATO); F.stats = (float*)(ws + WS_STATS); F.SH = (float*)(ws + WS_SH); F.SW = (float*)(ws + WS_SW); F.CMAX = (unsigned*)(ws + WS_CMAX); F.H8 = ws + WS_H8; F.W8 = ws + WS_W8; F.A8 = ws + WS_A8; F.B8 = ws + WS_B8; F.C8 = ws + WS_C8; F.M8 = ws + WS_M8; F.W8a = ws + WS_W8A; F.W8b = ws + WS_W8B; F.W8c = ws + WS_W8C; F.W8o = ws + WS_W8O;
    F.sA = (float*)(ws + WS_SX); F.sB = F.sA + 8192; F.sC = F.sB + 8192; F.sM = F.sC + 8192; F.SWa = F.sM + 8192; F.SWb = F.SWa + 4096; F.SWc = F.SWb + 4096; F.SWo = F.SWc + 4096;
    for (int u = F.tid; u < (LDS_BYTES - MISC_OFF) / 4; u += 512) ((LAS unsigned*)(F.lds + MISC_OFF))[u] = 0u;
    __syncthreads();
    XcdBarrier bar; bar.bar = (unsigned*)(ws + WS_CTL) + CW_BAR; bar.x = 0; bar.st = nullptr;
    if (MK_N_LAUNCHES == 1) bar = xcd_barrier_post((unsigned*)(ws + WS_CTL) + CW_BAR, MISC + 8);
    const int lo = args.ph_lo, hi = args.ph_hi;
#ifndef PHASE_MASK
#define PHASE_MASK 0x3ff
#endif
#define IN(k) (((PHASE_MASK >> (k)) & 1) && lo <= (k) && (k) < hi)
#define SEAM(k) do { if (IN(k) && IN((k) + 1)) xcd_barrier(bar); } while (0)
#ifndef REPEAT_PHASE
#define REPEAT_PHASE (-1)
#endif
#define REP(k) for (int rp_ = 0; rp_ < ((REPEAT_PHASE == (k)) ? 2 : 1); ++rp_, (void)((REPEAT_PHASE == (k) && rp_ == 1) ? (xcd_barrier(bar), 0) : 0))

    if (IN(0)) REP(0) { p0a_prologue(F); }
    SEAM(0);
    if (IN(1)) REP(1) {
        const int NGC = F.G >= 64 ? 32 : 0;
        if (NGC == 0 || F.cu < NGC) { pg8::Order S; S.init(F.MEMN, F.WmemT, 1024, 2048, NGC ? NGC : F.G, F.cu);
            EpiMem E{F.out + O_MK, F.out + O_MV, F.MKV};
            pg8::gemm_phase<EpiMem, pg8::Order, true>(F.lds, D, S, E); }
        if (NGC == 0 || F.cu >= NGC) { LAS float* scr = (LAS float*)(F.lds + F.wave * 8448);
            for (int it = (F.cu - NGC) * 8 + F.wave; it < 64 * 768; it += (F.G - NGC) * 8) p0_quant_item(F, scr, it, F.lane);
            for (int it = (F.cu - NGC) * 8 + F.wave; it < 4 * 4096; it += (F.G - NGC) * 8) { const int n = it & 4095;
                if (it < 4096) quant_row<AW>(F.WoaT + (size_t)n * AW, F.W8a, perm_slot(n), F.SWa + n, F.lane);
                else if (it < 8192) quant_row<RW>(F.WobT + (size_t)n * RW, F.W8b, perm_slot(n), F.SWb + n, F.lane);
                else if (it < 12288) quant_row<MW>(F.WocT + (size_t)n * MW, F.W8c, perm_slot(n), F.SWc + n, F.lane);
                else quant_row<D>(F.WoutT + (size_t)n * D, F.W8o, n, F.SWo + n, F.lane); } }
    }
    SEAM(1);
    if (IN(2)) REP(2) {
        { pg8::OrderP1 S{F.H, F.WinT, F.G, F.cu, 0}; EpiZ<false> E{F.Z, F.statv, F.ropec, F.ropes, F.SH, F.SW};
          pg8::gemm_phase<EpiZ<false>, pg8::OrderP1, true, false>(F.lds, D, S, E); }
        { pg8::OrderP1 S{F.H8, F.W8, F.G, F.cu, 1}; EpiZ<true> E{F.Z, F.statv, F.ropec, F.ropes, F.SH, F.SW};
          pg8::gemm_phase<EpiZ<true>, pg8::OrderP1, true, true>(F.lds, D, S, E); }
    }
    SEAM(2);
    if (IN(3)) REP(3) {
        const int NS = F.G >= 256 ? 128 : F.G;
        if (F.cu < NS) for (int u = F.cu; u < 256; u += NS) scan_unit(F, u >> 6, (u >> 3) & 7, u & 7);
        for (int u = F.cu; u < 512; u += F.G) spatial_unit(F, u >> 7, (u >> 3) & 15, (u >> 1) & 3, u & 1);
        for (int s = F.cu * 8 + F.wave; s < MS; s += F.G * 8) spatial_sample_row(F, s);
        { unsigned* q = (unsigned*)(ws + WS_CTL) + CW_Q;
          for (;;) { __syncthreads(); if (F.tid == 0) MISC[16] = __hip_atomic_fetch_add(q, 1u, __ATOMIC_RELAXED, __HIP_MEMORY_SCOPE_AGENT); __syncthreads();
              const unsigned it = MISC[16]; if (it >= 1536u) break;
              if (it < 1024u) ret_sample_item(F, (int)(it >> 3), (int)(it & 7)); else xattn_sample_item(F, (int)((it - 1024u) >> 2), (int)(it & 3)); } }
#ifdef DIAG_ZERO_Y
        for (size_t i = (size_t)F.cu * 512 + F.tid; i < (O_RP / 4); i += (size_t)F.G * 512) ((f32x4*)F.out)[i] = (f32x4){0.f, 0.f, 0.f, 0.f};
#endif
    }
    SEAM(3);
    if (IN(4)) REP(4) {
        for (int u = F.cu; u < 512; u += F.G) ret_out_unit(F, u >> 7, (u >> 4) & 7, u & 15);
        for (int u = F.cu; u < 256; u += F.G) xattn_unit(F, u >> 6, (u >> 4) & 3, u & 15);
        __syncthreads();
    }
    SEAM(4);
    if (IN(5)) {
        for (int it = F.cu * 8 + F.wave; it < 3 * MP; it += F.G * 8) { const int m = it % MP;
            if (it < MP) quant_row<AW>(F.AACT + (size_t)m * AW, F.A8, m, F.sA + m, F.lane);
            else if (it < 2 * MP) quant_row<RW>(F.BACT + (size_t)m * RW, F.B8, m, F.sB + m, F.lane);
            else quant_row<MW>(F.CACT + (size_t)m * MW, F.C8, m, F.sC + m, F.lane); }
        { const int w = F.wave, fr = F.lane & 15, fq = F.lane >> 4; const size_t row = (size_t)MP + 16 * w + fr;
          for (int nt = F.cu; nt < 256; nt += F.G) { const int n0 = 16 * nt;
              const f32x4 ya = skinny_dot<AW>(F.AACT + row * AW + 8 * fq, F.WoaT + (size_t)(n0 + fr) * AW + 8 * fq);
              const f32x4 yb = skinny_dot<RW>(F.BACT + row * RW + 8 * fq, F.WobT + (size_t)(n0 + fr) * RW + 8 * fq);
              const f32x4 yc = skinny_dot<MW>(F.CACT + row * MW + 8 * fq, F.WocT + (size_t)(n0 + fr) * MW + 8 * fq);
              const bf16_t* gz = F.Z + row * LDZ + ZC_GS + n0 + 4 * fq;
              const f32x4 g0 = unpk4(*(const u32x2*)gz), g1 = unpk4(*(const u32x2*)(gz + D)), g2 = unpk4(*(const u32x2*)(gz + 2 * D));
              *(u32x2*)(F.MG + row * D + n0 + 4 * fq) = pack4(g0 * ya + g1 * yb + g2 * yc); } }
    }
    SEAM(5);
    if (IN(6)) {
        for (int pass = 0; pass < 3; ++pass) {
            const unsigned char* A = pass == 0 ? F.A8 : (pass == 1 ? F.B8 : F.C8); const unsigned char* Bt = pass == 0 ? F.W8a : (pass == 1 ? F.W8b : F.W8c); const int K = pass == 2 ? MW : AW;
            pg8::Order S; S.init((const bf16_t*)A, (const bf16_t*)Bt, MP, D, F.G, F.cu);
            EpiMerge8 E{F.Z, F.MG, pass == 0 ? F.sA : (pass == 1 ? F.sB : F.sC), pass == 0 ? F.SWa : (pass == 1 ? F.SWb : F.SWc), pass};
            pg8::gemm_phase<EpiMerge8, pg8::Order, true, true>(F.lds, K, S, E);
        }
    }
    SEAM(6);
    if (IN(7)) {
        for (int m = F.cu * 8 + F.wave; m < MP; m += F.G * 8) quant_row<D>(F.MG + (size_t)m * D, F.M8, m, F.sM + m, F.lane);
        { const int w = F.wave, fr = F.lane & 15, fq = F.lane >> 4; const int r = 16 * w + fr; const size_t row = (size_t)MP + r;
          for (int nt = F.cu; nt < 256; nt += F.G) { const int n0 = 16 * nt;
              const f32x4 y = skinny_dot<D>(F.MG + row * D + 8 * fq, F.WoutT + (size_t)(n0 + fr) * D + 8 * fq);
              const f32x4 v = *(const f32x4*)(F.xs + (size_t)r * D + n0 + 4 * fq) + y;
              *(f32x4*)(F.out + O_YS + (size_t)r * D + n0 + 4 * fq) = v;
              float q = dot4(v, v); q += __shfl_xor(q, 16); q += __shfl_xor(q, 32);
              if (fq == 0) F.stats[r * 256 + nt] = q; } }
    }
    SEAM(7);
    if (IN(8)) {
        pg8::Order S; S.init((const bf16_t*)F.M8, (const bf16_t*)F.W8o, MP, D, F.G, F.cu);
        EpiOut8 E{F.xp, F.out + O_YP, F.stato, F.sM, F.SWo};
        pg8::gemm_phase<EpiOut8, pg8::Order, true, true>(F.lds, D, S, E);
    }
    SEAM(8);
    if (IN(9)) {
        const int lane = F.lane;
        for (int m = F.cu * 8 + F.wave; m < MREAL; m += F.G * 8) {
            float q; float* yr;
            if (m < MP) { q = wave_sum(F.stato[(size_t)m * 64 + lane]); yr = F.out + O_YP + (size_t)m * D; }
            else { const float* sp = F.stats + (size_t)(m - MP) * 256; q = wave_sum((sp[lane] + sp[lane + 64]) + (sp[lane + 128] + sp[lane + 192])); yr = F.out + O_YS + (size_t)(m - MP) * D; }
            const float r = 1.0f / sqrtf(q * (1.0f / 4096.0f) + EPS);
            f32x4* y4 = (f32x4*)yr + lane; const f32x4* g4 = (const f32x4*)F.g_final + lane;
            f32x4 v[16];
#pragma unroll
            for (int j = 0; j < 16; ++j) v[j] = y4[64 * j];
#pragma unroll
            for (int j = 0; j < 16; ++j) y4[64 * j] = v[j] * r * g4[64 * j];
        }
    }
#undef IN
#undef SEAM
}


__global__ void diag_hash(const unsigned char* ws, unsigned long long* table) {
    const unsigned* Z = (const unsigned*)(ws + WS_Z);
    const int segs[6] = {12288, 14336, 15360, 16384, 20480, 24576}; const int wid[6] = {2048, 1024, 1024, 4096, 4096, 4096};
    for (int r = 0; r < 6; ++r) { const int c0 = segs[r] / 2, nc = wid[r] / 2; unsigned long long h = 0;
        for (size_t i = (size_t)blockIdx.x * blockDim.x + threadIdx.x; i < (size_t)MPAD * nc; i += (size_t)gridDim.x * blockDim.x) { const size_t row = i / nc, c = i % nc; h += (unsigned long long)Z[row * (LDZ / 2) + c0 + c] * (unsigned long long)(i * 2654435761ull + 12345ull); }
        for (int o = 32; o >= 1; o >>= 1) h += __shfl_xor(h, o);
        if ((threadIdx.x & 63) == 0) atomicAdd(table + r, h); }
}
__global__ void diag_finish(float* out, const unsigned long long* t0, const unsigned long long* t1) {
    int mask = 0; for (int r = 0; r < 6; ++r) if (t0[r] != t1[r]) mask |= 1 << r;
    for (size_t i = (size_t)blockIdx.x * blockDim.x + threadIdx.x; i < O_END; i += (size_t)gridDim.x * blockDim.x) out[i] = (i == 0) ? __uint_as_float((unsigned)(127 + 10 + mask) << 23) : 0.f;
}
extern "C" void kernel_launch(void* const* d_in, const int* in_sizes, int n_in, void* d_out, int out_size, void* d_ws, size_t ws_size, hipStream_t stream) {
    static int grid = 0;
    if (grid == 0) {
        if (n_in != 19 || out_size != (int)O_END || ws_size < WS_END) { fprintf(stderr, "kernel_launch: unexpected problem shape (n_in %d, out %d, ws %zu); nothing launched\n", n_in, out_size, ws_size); grid = -1; return; }
        int dev = 0, cus = 0, per_cu = 0;
        if (hipGetDevice(&dev) != hipSuccess || hipDeviceGetAttribute(&cus, hipDeviceAttributeMultiprocessorCount, dev) != hipSuccess) { grid = -1; return; }
        if (hipFuncSetAttribute((const void*)mega_fwd, hipFuncAttributeMaxDynamicSharedMemorySize, LDS_BYTES) != hipSuccess) { fprintf(stderr, "kernel_launch: hipFuncSetAttribute failed\n"); grid = -1; return; }
        if (hipOccupancyMaxActiveBlocksPerMultiprocessor(&per_cu, (const void*)mega_fwd, 512, LDS_BYTES) != hipSuccess || per_cu < 1) fprintf(stderr, "kernel_launch: occupancy query says %d blocks per CU\n", per_cu);
        (void)hipGetLastError();
        grid = cus;
    }
    if (grid < 0) return;
    (void)hipMemsetAsync((char*)d_ws + WS_CTL, 0, CTL_ZERO_BYTES, stream);
    Args a{};
    for (int i = 0; i < 19; ++i) a.in[i] = (const float*)d_in[i];
    a.out = (float*)d_out; a.ws = (unsigned char*)d_ws;
#ifdef DIAG_DET
    for (int rep = 0; rep < 2; ++rep) { a.ph_lo = 0; a.ph_hi = 2; if (rep) (void)hipMemsetAsync((char*)d_ws + WS_CTL, 0, 32 * 1024, stream);
        hipLaunchKernelGGL(mega_fwd, dim3(grid), dim3(512), LDS_BYTES, stream, a);
        hipLaunchKernelGGL(diag_hash, dim3(1024), dim3(256), 0, stream, (const unsigned char*)d_ws, (unsigned long long*)((char*)d_ws + 32 * 1024 + rep * 1024)); }
    hipLaunchKernelGGL(diag_finish, dim3(1024), dim3(256), 0, stream, (float*)d_out, (const unsigned long long*)((char*)d_ws + 32 * 1024), (const unsigned long long*)((char*)d_ws + 33 * 1024));
    return;
#endif
    if (MK_N_LAUNCHES == 1) { a.ph_lo = 0; a.ph_hi = 10; hipLaunchKernelGGL(mega_fwd, dim3(grid), dim3(512), LDS_BYTES, stream, a); }
    else { for (int p = 0; p < 10; ++p) { a.ph_lo = p; a.ph_hi = p + 1; hipLaunchKernelGGL(mega_fwd, dim3(grid), dim3(512), LDS_BYTES, stream, a); } }
}
```
